# Optimizing an MI355X kernel written in HIP

```python
import jax, jax.numpy as jnp
from jax import lax
import numpy as np

D_MODEL = 1024
BATCH = 8
SEQ = 4096
DEPTH = 2

HEAD_DIM = 64
ROPE_THETA = 10000.0
EPS = 1e-6
NEG = -1e30
D_FF = 4 * D_MODEL
N_MEM = 256
MEM_HEADS = 4
NSA_HEADS = 12
NSA_KV_HEADS = 3
NSA_GQA = NSA_HEADS // NSA_KV_HEADS
CMP_BLOCK = 32
CMP_STRIDE = 16
CMP_HIDDEN = 256
SEL_BLOCK = 64
SEL_TOPK = 16
WINDOW = 512
NSA_Q_BLOCK = 32
SEL_FORCE = 1e9
DIL_PATTERNS = ((128, 1), (512, 4), (2048, 16))
N_DIL_GROUPS = 3
DIL_SLOTS = 8
DIL_Q_BLOCK = 64
N_A_LAYERS = DEPTH // 2
N_B_LAYERS = DEPTH - N_A_LAYERS
MEM_W = MEM_HEADS * HEAD_DIM
A_Q = NSA_HEADS * HEAD_DIM
A_KV = NSA_KV_HEADS * HEAD_DIM
A_GATES = 3 * NSA_HEADS
A_IN = A_Q + 6 * A_KV + MEM_W + A_GATES
A_OUT = A_Q + MEM_W
A_SPLITS = (A_Q, A_Q + A_KV, A_Q + 2 * A_KV, A_Q + 3 * A_KV, A_Q + 4 * A_KV, A_Q + 5 * A_KV, A_Q + 6 * A_KV, A_Q + 6 * A_KV + MEM_W)
B_Q = N_DIL_GROUPS * DIL_SLOTS * HEAD_DIM
B_IN = B_Q + MEM_W
B_OUT = DIL_SLOTS * HEAD_DIM + MEM_W
SHARED_KV = 2 * DIL_SLOTS * HEAD_DIM

kernel_name = "yoco_nsa_dilated_hybrid"


def rmsnorm(x, g):
    x32 = x.astype(jnp.float32)
    y = x32 * lax.rsqrt(jnp.mean(x32 * x32, axis=-1, keepdims=True) + EPS)
    return (y * g.astype(jnp.float32)).astype(x.dtype)


def rope(x, pos):
    half = x.shape[-1] // 2
    inv_freq = ROPE_THETA ** (-jnp.arange(half, dtype=jnp.float32) / half)
    ang = jnp.asarray(pos, jnp.float32)[:, None] * inv_freq[None, :]
    cos = jnp.cos(ang).astype(x.dtype)
    sin = jnp.sin(ang).astype(x.dtype)
    x1, x2 = x[..., :half], x[..., half:]
    return jnp.concatenate([x1 * cos - x2 * sin, x1 * sin + x2 * cos], axis=-1)


def split_heads(x, n):
    b, s, _ = x.shape
    return x.reshape(b, s, n, HEAD_DIM).transpose(0, 2, 1, 3)


def merge_heads(x):
    b, h, s, d = x.shape
    return x.transpose(0, 2, 1, 3).reshape(b, s, h * d)


def chunk_seq(x, axis, size):
    shp = x.shape
    x = x.reshape(shp[:axis] + (shp[axis] // size, size) + shp[axis + 1:])
    return jnp.moveaxis(x, axis, 0)


def unchunk_seq(y, axis):
    y = jnp.moveaxis(y, 0, axis)
    shp = y.shape
    return y.reshape(shp[:axis] + (shp[axis] * shp[axis + 1],) + shp[axis + 2:])


def masked_softmax(s, mask):
    return jax.nn.softmax(jnp.where(mask, s.astype(jnp.float32), NEG), axis=-1)


def nsa_attention(q, k_cmp, v_cmp, k_sel, v_sel, k_win, v_win, gate_logits,
                  q_norm, k_norm, cmp_pos, cmp_w1, cmp_b1, cmp_w2, cmp_b2):
    B, S, _ = q.shape
    G, R, D, QB = NSA_KV_HEADS, NSA_GQA, HEAD_DIM, NSA_Q_BLOCK
    scale = D ** -0.5
    pos = jnp.arange(S)
    q = rope(rmsnorm(split_heads(q, NSA_HEADS), q_norm), pos).reshape(B, G, R, S, D)
    k_sel = rope(rmsnorm(split_heads(k_sel, G), k_norm[1]), pos)
    v_sel = split_heads(v_sel, G)
    k_win = rope(rmsnorm(split_heads(k_win, G), k_norm[2]), pos)
    v_win = split_heads(v_win, G)

    n_cmp = (S - CMP_BLOCK) // CMP_STRIDE + 1
    blk_tok = np.arange(n_cmp)[:, None] * CMP_STRIDE + np.arange(CMP_BLOCK)[None, :]
    cmp_end = jnp.asarray(blk_tok[:, -1], jnp.int32)

    def compress(t, i):
        tb = (t[:, :, blk_tok] + cmp_pos[i]).reshape(B, G, n_cmp, CMP_BLOCK * D)
        return jax.nn.gelu(tb @ cmp_w1[i] + cmp_b1[i]) @ cmp_w2[i] + cmp_b2[i]

    k_c = rope(rmsnorm(compress(split_heads(k_cmp, G), 0), k_norm[0]), cmp_end)
    v_c = compress(split_heads(v_cmp, G), 1)

    n_blk = S // SEL_BLOCK
    n_sel = min(SEL_TOPK, n_blk)
    c_start = np.arange(n_cmp)[:, None] * CMP_STRIDE
    b_start = np.arange(n_blk)[None, :] * SEL_BLOCK
    overlap = jnp.asarray((c_start < b_start + SEL_BLOCK) & (c_start + CMP_BLOCK > b_start), jnp.float32)
    k_sel_blk = k_sel.reshape(B, G, n_blk, SEL_BLOCK, D)
    v_sel_blk = v_sel.reshape(B, G, n_blk, SEL_BLOCK, D)
    k_win_pad = jnp.pad(k_win, ((0, 0), (0, 0), (WINDOW, 0), (0, 0)))
    v_win_pad = jnp.pad(v_win, ((0, 0), (0, 0), (WINDOW, 0), (0, 0)))
    b_ix = jnp.arange(B)[:, None, None, None]
    g_ix = jnp.arange(G)[None, :, None, None]
    blk_ids = jnp.arange(n_blk)

    gates = jax.nn.sigmoid(gate_logits).reshape(B, S, NSA_HEADS, 3)
    gates = gates.transpose(0, 2, 1, 3).reshape(B, G, R, S, 3)

    def block(args):
        c, q_b, g_b = args
        t = c * QB + jnp.arange(QB)
        m_c = cmp_end[None, :] <= t[:, None]
        p_c = masked_softmax(jnp.einsum('bgrqd,bgcd->bgrqc', q_b, k_c) * scale, m_c)
        o_c = jnp.einsum('bgrqc,bgcd->bgrqd', p_c.astype(v_c.dtype), v_c)
        o_c = jnp.where(m_c.any(-1)[:, None], o_c, 0)
        imp = jnp.einsum('bgqc,cj->bgqj', p_c.sum(axis=2), overlap)
        cur = (t // SEL_BLOCK)[:, None]
        forced = (blk_ids == 0) | (blk_ids == cur) | (blk_ids == cur - 1)
        imp = jnp.where(forced, SEL_FORCE, jnp.where(blk_ids <= cur, imp, NEG))
        top_v, top_i = lax.top_k(imp, n_sel)
        k_g = k_sel_blk[b_ix, g_ix, top_i].reshape(B, G, QB, n_sel * SEL_BLOCK, D)
        v_g = v_sel_blk[b_ix, g_ix, top_i].reshape(B, G, QB, n_sel * SEL_BLOCK, D)
        key_pos = top_i[..., None] * SEL_BLOCK + jnp.arange(SEL_BLOCK)
        m_s = (key_pos <= t[:, None, None]) & (top_v > NEG / 2)[..., None]
        m_s = m_s.reshape(B, G, 1, QB, n_sel * SEL_BLOCK)
        p_s = masked_softmax(jnp.einsum('bgrqd,bgqkd->bgrqk', q_b, k_g) * scale, m_s)
        o_s = jnp.einsum('bgrqk,bgqkd->bgrqd', p_s.astype(v_g.dtype), v_g)
        k_b = lax.dynamic_slice_in_dim(k_win_pad, c * QB, QB + WINDOW, axis=2)
        v_b = lax.dynamic_slice_in_dim(v_win_pad, c * QB, QB + WINDOW, axis=2)
        kpos = c * QB - WINDOW + jnp.arange(QB + WINDOW)
        dist = t[:, None] - kpos[None, :]
        m_w = (kpos[None, :] >= 0) & (dist >= 0) & (dist < WINDOW)
        p_w = masked_softmax(jnp.einsum('bgrqd,bgkd->bgrqk', q_b, k_b) * scale, m_w)
        o_w = jnp.einsum('bgrqk,bgkd->bgrqd', p_w.astype(v_b.dtype), v_b)
        return g_b[..., 0:1] * o_c + g_b[..., 1:2] * o_s + g_b[..., 2:3] * o_w

    n_chunks = S // QB
    out = lax.map(block, (jnp.arange(n_chunks), chunk_seq(q, 3, QB), chunk_seq(gates, 3, QB)))
    out = unchunk_seq(out, 3).reshape(B, NSA_HEADS, S, D)
    return merge_heads(out)


def dilated_attention(q, k, v, q_norm):
    B, S, _ = q.shape
    H, D, QB = DIL_SLOTS, HEAD_DIM, DIL_Q_BLOCK
    scale = D ** -0.5
    q = q.reshape(B, S, N_DIL_GROUPS, H, D).transpose(0, 2, 3, 1, 4)
    q = rope(rmsnorm(q, q_norm[:, None, None, :]), jnp.arange(S))

    def block(args):
        c, q_b = args
        t = c * QB + jnp.arange(QB)
        outs, lses = [], []
        for gi, (window, dil) in enumerate(DIL_PATTERNS):
            n_k = window // dil + 1
            idx = t[:, None] - dil * jnp.arange(n_k)[None, :]
            valid = idx >= 0
            idx = jnp.maximum(idx, 0)
            k_g = jnp.take(k, idx, axis=2)
            v_g = jnp.take(v, idx, axis=2)
            s = jnp.einsum('bhqd,bhqkd->bhqk', q_b[:, gi], k_g).astype(jnp.float32) * scale
            s = jnp.where(valid, s, NEG)
            lse = jax.nn.logsumexp(s, axis=-1, keepdims=True)
            p = jnp.exp(s - lse)
            outs.append(jnp.einsum('bhqk,bhqkd->bhqd', p.astype(v.dtype), v_g))
            lses.append(lse)
        wts = jax.nn.softmax(jnp.stack(lses), axis=0).astype(v.dtype)
        return jnp.sum(jnp.stack(outs) * wts, axis=0)

    out = lax.map(block, (jnp.arange(S // QB), chunk_seq(q, 3, QB)))
    return merge_heads(unchunk_seq(out, 2))


def memory_attention(q, mem_kv, q_norm, k_norm):
    scale = HEAD_DIM ** -0.5
    q = rmsnorm(split_heads(q, MEM_HEADS), q_norm)
    k, v = jnp.split(mem_kv, 2, axis=-1)
    k = rmsnorm(split_heads(k, MEM_HEADS), k_norm)
    v = split_heads(v, MEM_HEADS)
    p = jax.nn.softmax(jnp.einsum('bhqd,bhmd->bhqm', q, k).astype(jnp.float32) * scale, axis=-1)
    return merge_heads(jnp.einsum('bhqm,bhmd->bhqd', p.astype(v.dtype), v))


def squared_relu_mlp(h, w_up, w_down):
    return jnp.square(jax.nn.relu(h @ w_up)) @ w_down


def setup_inputs(seed: int = 0) -> dict:
    key = jax.random.key(seed)
    keys = jax.random.split(key, 25)
    cnt = [0]

    def nk():
        k = keys[cnt[0]]
        cnt[0] += 1
        return k

    def normal(shape, scale):
        return scale * jax.random.normal(nk(), shape, jnp.float32)

    def gain(shape):
        return 1.0 + 0.05 * jax.random.normal(nk(), shape, jnp.float32)

    NA, NB = N_A_LAYERS, N_B_LAYERS
    return {
        "x": normal((BATCH, SEQ, D_MODEL), 1.0),
        "mem": normal((BATCH, N_MEM, D_MODEL), 1.0),
        "attn_norm": gain((DEPTH, D_MODEL)),
        "mlp_norm": gain((DEPTH, D_MODEL)),
        "w_up": normal((DEPTH, D_MODEL, D_FF), D_MODEL ** -0.5),
        "w_down": normal((DEPTH, D_FF, D_MODEL), D_FF ** -0.5),
        "mem_norm": gain((DEPTH, D_MODEL)),
        "w_mem_kv": normal((DEPTH, D_MODEL, 2 * MEM_W), D_MODEL ** -0.5),
        "mem_q_norm": gain((DEPTH, HEAD_DIM)),
        "mem_k_norm": gain((DEPTH, HEAD_DIM)),
        "a_w_in": normal((NA, D_MODEL, A_IN), D_MODEL ** -0.5),
        "a_w_out": normal((NA, A_OUT, D_MODEL), A_OUT ** -0.5),
        "a_q_norm": gain((NA, HEAD_DIM)),
        "a_k_norm": gain((NA, 3, HEAD_DIM)),
        "a_cmp_pos": normal((NA, 2, CMP_BLOCK, HEAD_DIM), 0.1),
        "a_cmp_w1": normal((NA, 2, CMP_BLOCK * HEAD_DIM, CMP_HIDDEN), (CMP_BLOCK * HEAD_DIM) ** -0.5),
        "a_cmp_b1": normal((NA, 2, CMP_HIDDEN), 0.01),
        "a_cmp_w2": normal((NA, 2, CMP_HIDDEN, HEAD_DIM), CMP_HIDDEN ** -0.5),
        "a_cmp_b2": normal((NA, 2, HEAD_DIM), 0.01),
        "kv_norm": gain((D_MODEL,)),
        "w_kv_shared": normal((D_MODEL, SHARED_KV), D_MODEL ** -0.5),
        "kv_k_norm": gain((HEAD_DIM,)),
        "b_w_in": normal((NB, D_MODEL, B_IN), D_MODEL ** -0.5),
        "b_w_out": normal((NB, B_OUT, D_MODEL), B_OUT ** -0.5),
        "b_q_norm": gain((NB, N_DIL_GROUPS, HEAD_DIM)),
    }


def reference(x, mem, attn_norm, mlp_norm, w_up, w_down, mem_norm, w_mem_kv, mem_q_norm, mem_k_norm,
              a_w_in, a_w_out, a_q_norm, a_k_norm, a_cmp_pos, a_cmp_w1, a_cmp_b1, a_cmp_w2, a_cmp_b2,
              kv_norm, w_kv_shared, kv_k_norm, b_w_in, b_w_out, b_q_norm):
    pos = jnp.arange(x.shape[1])
    k_shared = None
    v_shared = None
    for layer in range(DEPTH):
        h = rmsnorm(x, attn_norm[layer])
        mem_kv = rmsnorm(mem, mem_norm[layer]) @ w_mem_kv[layer]
        if layer < N_A_LAYERS:
            i = layer
            q, kc, vc, ks, vs, kw, vw, q_mem, gl = jnp.split(h @ a_w_in[i], A_SPLITS, axis=-1)
            o_main = nsa_attention(q, kc, vc, ks, vs, kw, vw, gl, a_q_norm[i], a_k_norm[i],
                                   a_cmp_pos[i], a_cmp_w1[i], a_cmp_b1[i], a_cmp_w2[i], a_cmp_b2[i])
            o_mem = memory_attention(q_mem, mem_kv, mem_q_norm[layer], mem_k_norm[layer])
            x = x + jnp.concatenate([o_main, o_mem], axis=-1) @ a_w_out[i]
        else:
            i = layer - N_A_LAYERS
            if i == 0:
                k_s, v_s = jnp.split(rmsnorm(x, kv_norm) @ w_kv_shared, 2, axis=-1)
                k_shared = rope(rmsnorm(split_heads(k_s, DIL_SLOTS), kv_k_norm), pos)
                v_shared = split_heads(v_s, DIL_SLOTS)
            q, q_mem = jnp.split(h @ b_w_in[i], [B_Q], axis=-1)
            o_main = dilated_attention(q, k_shared, v_shared, b_q_norm[i])
            o_mem = memory_attention(q_mem, mem_kv, mem_q_norm[layer], mem_k_norm[layer])
            x = x + jnp.concatenate([o_main, o_mem], axis=-1) @ b_w_out[i]
        x = x + squared_relu_mlp(rmsnorm(x, mlp_norm[layer]), w_up[layer], w_down[layer])
    return x
```

```cpp
#include <hip/hip_runtime.h>
#include <hip/hip_cooperative_groups.h>
#include <cstdio>
#include <cstdint>
namespace cg = cooperative_groups;
namespace pg8 {
#define PG8_LAS __attribute__((address_space(3)))
typedef unsigned short bf16_t;
typedef short bf16x8 __attribute__((ext_vector_type(8)));
typedef float f32x4 __attribute__((ext_vector_type(4)));
typedef unsigned u32x4 __attribute__((ext_vector_type(4)));
constexpr int BM = 256, BK = 64, HALF = 128, HTB = HALF * BK * 2  , STAGE_BYTES = 8 * HTB, NXCD = 8, WGM = 8;

__host__ __device__ __forceinline__ int lds_byte(int r, int c) { const int st = (r >> 4) * 2 + (c >> 5), rr = r & 15, cc = c & 31, ob = rr * 64 + cc * 2; return st * 1024 + (ob ^ (((ob >> 9) & 1) << 5)); }
__host__ __device__ __forceinline__ void stage_rc(int b, int& R, int& C) { const int st = b / 1024, sb = b % 1024, swz = sb ^ (((sb >> 9) & 1) << 5); R = (st >> 1) * 16 + swz / 64; C = (st & 1) * 32 + (swz % 64) / 2; }
__host__ __device__ __forceinline__ int perm32(int rho) { const int n = rho >> 4, i = rho & 15; return 8 * (i >> 2) + 4 * n + (i & 3); }

struct Unit { int pm, pn; };
struct Gemm { const bf16_t* A; const bf16_t* Bt; int M, N, K; };

struct StaticOrder {
    int nM, nN, nwg, G, c;
    __host__ __device__ void init(int M, int N, int G_, int c_) { nM = M / BM; nN = N / BM; nwg = nM * nN; G = G_; c = c_; }
    __host__ __device__ bool next(int i, Unit& u) const {
        const long L = (long)i * G + c; if (L >= nwg) return false;
        int wgid = (int)L; { const int q = nwg / NXCD, r = nwg % NXCD, xcd = wgid % NXCD, off = wgid / NXCD; wgid = (xcd < r ? xcd * (q + 1) : r * (q + 1) + (xcd - r) * q) + off; }
        const int nig = WGM * nN, gid = wgid / nig, fm = gid * WGM, gsz = (nM - fm) < WGM ? (nM - fm) : WGM;
        u.pm = fm + ((wgid % nig) % gsz); u.pn = (wgid % nig) / gsz; return true;
    }
    __device__ __forceinline__ void a_ready(const Unit&) const {}
    __device__ __forceinline__ void done(const Unit&) const {}
};

__device__ __forceinline__ unsigned cvt_pk_bf16(float lo, float hi) { unsigned r; asm volatile("v_cvt_pk_bf16_f32 %0, %1, %2" : "=v"(r) : "v"(lo), "v"(hi)); return r; }
__device__ __forceinline__ float gelu_tanh(float x) {
    const float u = 0.7978845608028654f * (x + 0.044715f * x * x * x);
    const float e = __builtin_amdgcn_exp2f(u * 2.885390081777927f);
    const float th = 1.0f - 2.0f * __builtin_amdgcn_rcpf(1.0f + e);
    return 0.5f * x * (1.0f + th);
}
template <int ACT> struct EpiStore {
    static constexpr bool PERM = true, AFTER_DRAIN = false;
    bf16_t* O; int ldc; const float* bias; const float* rowss;
    __device__ __forceinline__ void operator()(const f32x4 (&acc)[2][2][4][2], const Unit& u, int wr, int wc, int fr, int fq) const {
        const int row0 = u.pm * BM + wr * 64 + fr; const int col0 = u.pn * BM + wc * 32 + 8 * fq;
        f32x4 bv[2][2];
#pragma unroll
        for (int bj = 0; bj < 2; ++bj)
#pragma unroll
            for (int n = 0; n < 2; ++n) bv[bj][n] = (ACT == 1) ? *(const f32x4*)(bias + col0 + bj * HALF + 4 * n) : (f32x4){0.f, 0.f, 0.f, 0.f};
#pragma unroll
        for (int ai = 0; ai < 2; ++ai)
#pragma unroll
            for (int m = 0; m < 4; ++m) { bf16_t* rowp = O + (size_t)(row0 + ai * HALF + m * 16) * ldc + col0;
                float rs = 1.0f; if (rowss) rs = 1.0f / sqrtf(rowss[row0 + ai * HALF + m * 16] * (1.0f / 1024.0f) + 1e-6f);
                if (ACT == 2) rs = rs * rs;
#pragma unroll
                for (int bj = 0; bj < 2; ++bj) { f32x4 v0 = acc[ai][bj][m][0], v1 = acc[ai][bj][m][1];
                    if (ACT == 1) { v0 = v0 + bv[bj][0]; v1 = v1 + bv[bj][1];
#pragma unroll
                        for (int e = 0; e < 4; ++e) { v0[e] = gelu_tanh(v0[e]); v1[e] = gelu_tanh(v1[e]); } }
                    if (ACT == 2) {
#pragma unroll
                        for (int e = 0; e < 4; ++e) { float a = fmaxf(v0[e], 0.f), b = fmaxf(v1[e], 0.f); v0[e] = a * a; v1[e] = b * b; } }
                    v0 = v0 * rs; v1 = v1 * rs;
                    u32x4 w; w.x = cvt_pk_bf16(v0[0], v0[1]); w.y = cvt_pk_bf16(v0[2], v0[3]); w.z = cvt_pk_bf16(v1[0], v1[1]); w.w = cvt_pk_bf16(v1[2], v1[3]);
                    *(u32x4*)(rowp + bj * HALF) = w; } }
    }
};
struct EpiRes {
    static constexpr bool PERM = true, AFTER_DRAIN = false;
    const float* basef; const bf16_t* baseh; float* outf; int ldc; bf16_t* hb; bf16_t* hb2; float* rowss;
    __device__ __forceinline__ void operator()(const f32x4 (&acc)[2][2][4][2], const Unit& u, int wr, int wc, int fr, int fq) const {
        const int row0 = u.pm * BM + wr * 64 + fr; const int col0 = u.pn * BM + wc * 32 + 8 * fq;
        float ss[8];
#pragma unroll
        for (int ai = 0; ai < 2; ++ai)
#pragma unroll
            for (int m = 0; m < 4; ++m) { const size_t off = (size_t)(row0 + ai * HALF + m * 16) * ldc + col0;
                float ssq = 0.f;
#pragma unroll
                for (int bj = 0; bj < 2; ++bj) {
                    f32x4 b0, b1;
                    if (basef) { b0 = *(const f32x4*)(basef + off + bj * HALF); b1 = *(const f32x4*)(basef + off + bj * HALF + 4); }
                    else { const u32x4 r = *(const u32x4*)(baseh + off + bj * HALF);
                        b0 = (f32x4){__builtin_bit_cast(float, r.x << 16), __builtin_bit_cast(float, r.x & 0xffff0000u), __builtin_bit_cast(float, r.y << 16), __builtin_bit_cast(float, r.y & 0xffff0000u)};
                        b1 = (f32x4){__builtin_bit_cast(float, r.z << 16), __builtin_bit_cast(float, r.z & 0xffff0000u), __builtin_bit_cast(float, r.w << 16), __builtin_bit_cast(float, r.w & 0xffff0000u)}; }
                    const f32x4 n0 = b0 + acc[ai][bj][m][0], n1 = b1 + acc[ai][bj][m][1];
                    if (outf) { *(f32x4*)(outf + off + bj * HALF) = n0; *(f32x4*)(outf + off + bj * HALF + 4) = n1; }
                    if (hb) { ssq += (n0[0] * n0[0] + n0[1] * n0[1]) + (n0[2] * n0[2] + n0[3] * n0[3]) + (n1[0] * n1[0] + n1[1] * n1[1]) + (n1[2] * n1[2] + n1[3] * n1[3]);
                        u32x4 w; w.x = cvt_pk_bf16(n0[0], n0[1]); w.y = cvt_pk_bf16(n0[2], n0[3]); w.z = cvt_pk_bf16(n1[0], n1[1]); w.w = cvt_pk_bf16(n1[2], n1[3]);
                        *(u32x4*)(hb + off + bj * HALF) = w; if (hb2) *(u32x4*)(hb2 + off + bj * HALF) = w; } }
                if (hb) { ssq += __shfl_xor(ssq, 16); ssq += __shfl_xor(ssq, 32); }
                ss[ai * 4 + m] = ssq; }
        if (hb) {
            const float va = fq == 0 ? ss[0] : (fq == 1 ? ss[1] : (fq == 2 ? ss[2] : ss[3]));
            const float vb = fq == 0 ? ss[4] : (fq == 1 ? ss[5] : (fq == 2 ? ss[6] : ss[7]));
            (void)__hip_atomic_fetch_add(rowss + row0 + fq * 16, va, __ATOMIC_RELAXED, __HIP_MEMORY_SCOPE_AGENT);
            (void)__hip_atomic_fetch_add(rowss + row0 + HALF + fq * 16, vb, __ATOMIC_RELAXED, __HIP_MEMORY_SCOPE_AGENT);
        }
    }
};
template <class Epi, class Sched, bool ALIGN_EPI = false, bool SP2 = false>
__device__ __forceinline__ void gemm_phase(PG8_LAS unsigned char* lds, const Gemm g, const Sched& S, const Epi& E) {
    int tid_ = threadIdx.x; asm volatile("" : "+v"(tid_));
    const int tid = tid_, wid = __builtin_amdgcn_readfirstlane(tid >> 6), lane = tid & 63, wr = wid >> 2, wc = wid & 3, fr = lane & 15, fq = lane >> 4;
    const int K = g.K, nt = K / BK;
    unsigned voffA[2], voffB[2];
#pragma unroll
    for (int i = 0; i < 2; ++i) { int R, C; stage_rc(tid * 16 + i * 8192, R, C); const int Rb = Epi::PERM ? ((R & ~31) + perm32(R & 31)) : R;
        voffA[i] = (unsigned)(R * K + C) * 2u; voffB[i] = (unsigned)(Rb * K + C) * 2u; }
    const size_t kstep = (size_t)(BK * 2);
    const size_t hstep = (size_t)HALF * K * 2;
    const size_t tstep = 2 * hstep;
    const unsigned ldsw = (unsigned)wid * 1024u;
    const int aoff = lds_byte(wr * 64 + fr, fq * 8), boff = lds_byte(wc * 32 + fr, fq * 8);
#define PG8_SA(b, h) (((b) * 2 + (h)) * HTB)
#define PG8_SB(b, h) ((4 + (b) * 2 + (h)) * HTB)
#define PG8_STAGE(bufoff, gbase, voff) do { _Pragma("unroll") for (int _i = 0; _i < 2; ++_i) \
        __builtin_amdgcn_global_load_lds((const unsigned*)((const char*)(gbase) + (voff)[_i]), (PG8_LAS unsigned*)(lds + (bufoff) + ldsw + _i * 8192), 16, 0, 0); } while (0)
#define PG8_LDA(dst, b, h) do { _Pragma("unroll") for (int m = 0; m < 4; ++m) _Pragma("unroll") for (int k = 0; k < 2; ++k) dst[m][k] = *(const PG8_LAS bf16x8*)(lds + PG8_SA(b, h) + aoff + m * 2048 + k * 1024); } while (0)
#define PG8_LDB(dst, b, h) do { _Pragma("unroll") for (int n = 0; n < 2; ++n) _Pragma("unroll") for (int k = 0; k < 2; ++k) dst[n][k] = *(const PG8_LAS bf16x8*)(lds + PG8_SB(b, h) + boff + n * 2048 + k * 1024); } while (0)
#define PG8_MMA(ai, bj, At, Bt) do { __builtin_amdgcn_s_setprio(1); _Pragma("unroll") for (int m = 0; m < 4; ++m) _Pragma("unroll") for (int n = 0; n < 2; ++n) _Pragma("unroll") for (int k = 0; k < 2; ++k) \
        acc[ai][bj][m][n] = __builtin_amdgcn_mfma_f32_16x16x32_bf16(Bt[n][k], At[m][k], acc[ai][bj][m][n], 0, 0, 0); __builtin_amdgcn_s_setprio(0); } while (0)
#define PG8_WAIT_V(n) asm volatile("s_waitcnt vmcnt(" #n ")" ::: "memory")
#define PG8_WAIT_L(n) asm volatile("s_waitcnt lgkmcnt(" #n ")" ::: "memory")
#define PG8_BAR __builtin_amdgcn_s_barrier()
#define PG8_SCHED __builtin_amdgcn_sched_barrier(0)
    Unit cur, nxt; int ui = 0;
    if (!S.next(0, cur)) return;
    f32x4 acc[2][2][4][2];
#pragma unroll
    for (int a = 0; a < 2; ++a)
#pragma unroll
        for (int b = 0; b < 2; ++b)
#pragma unroll
            for (int m = 0; m < 4; ++m)
#pragma unroll
                for (int n = 0; n < 2; ++n) acc[a][b][m][n] = (f32x4){0.f, 0.f, 0.f, 0.f};
    bf16x8 At[4][2], B0[2][2], B1[2][2];
    const char* cA = (const char*)g.A + (size_t)cur.pm * tstep; const char* cB = (const char*)g.Bt + (size_t)cur.pn * tstep;
    S.a_ready(cur);
    if constexpr (SP2) {
        PG8_STAGE(PG8_SB(0, 0), cB, voffB); PG8_STAGE(PG8_SB(0, 1), cB + hstep, voffB); PG8_STAGE(PG8_SA(0, 0), cA, voffA); PG8_STAGE(PG8_SA(0, 1), cA + hstep, voffA);
        if (wr == 1) PG8_BAR;
        PG8_WAIT_V(2); PG8_BAR;
        PG8_STAGE(PG8_SB(1, 0), cB + kstep, voffB); PG8_STAGE(PG8_SA(1, 0), cA + kstep, voffA); PG8_STAGE(PG8_SB(1, 1), cB + hstep + kstep, voffB);
        PG8_WAIT_V(6); PG8_BAR;
    } else {
        PG8_STAGE(PG8_SB(0, 0), cB, voffB); PG8_STAGE(PG8_SA(0, 0), cA, voffA); PG8_STAGE(PG8_SB(0, 1), cB + hstep, voffB); PG8_STAGE(PG8_SA(0, 1), cA + hstep, voffA);
        if (wr == 1) PG8_BAR;
        PG8_WAIT_V(4); PG8_BAR;
        PG8_STAGE(PG8_SB(1, 0), cB + kstep, voffB); PG8_STAGE(PG8_SA(1, 0), cA + kstep, voffA); PG8_STAGE(PG8_SB(1, 1), cB + hstep + kstep, voffB);
        PG8_WAIT_V(6); PG8_BAR;
    }
    for (;;) {
        const bool has_next = S.next(ui + 1, nxt);
        const char* nA = has_next ? (const char*)g.A + (size_t)nxt.pm * tstep : cA; const char* nB = has_next ? (const char*)g.Bt + (size_t)nxt.pn * tstep : cB;
        for (int t = 0; t < nt; t += 2) {
            const bool last = (t == nt - 2);
            const char* a1 = cA + (size_t)(t + 1) * kstep;
            const char* a2 = last ? nA : cA + (size_t)(t + 2) * kstep; const char* b2 = last ? nB : cB + (size_t)(t + 2) * kstep;
            const char* a3 = a2 + kstep; const char* b3 = b2 + kstep;
            if (last && has_next) S.a_ready(nxt);
            if constexpr (SP2) {
            PG8_LDB(B0, 0, 0); PG8_LDB(B1, 0, 1); PG8_SCHED; PG8_LDA(At, 0, 0); PG8_STAGE(PG8_SA(1, 1), a1 + hstep, voffA);
            PG8_WAIT_V(8); PG8_WAIT_L(0); PG8_BAR; PG8_MMA(0, 0, At, B0); PG8_MMA(0, 1, At, B1); PG8_BAR; PG8_SCHED;
            PG8_LDA(At, 0, 1); PG8_STAGE(PG8_SB(0, 0), b2, voffB); PG8_STAGE(PG8_SB(0, 1), b2 + hstep, voffB); PG8_STAGE(PG8_SA(0, 0), a2, voffA);
            PG8_WAIT_V(8); PG8_WAIT_L(0); PG8_BAR; PG8_MMA(1, 0, At, B0); PG8_MMA(1, 1, At, B1); PG8_BAR; PG8_SCHED;
            PG8_LDB(B0, 1, 0); PG8_LDB(B1, 1, 1); PG8_SCHED; PG8_LDA(At, 1, 0); PG8_STAGE(PG8_SA(0, 1), a2 + hstep, voffA);
            PG8_WAIT_V(8); PG8_WAIT_L(0); PG8_BAR; PG8_MMA(0, 0, At, B0); PG8_MMA(0, 1, At, B1); PG8_BAR; PG8_SCHED;
            PG8_LDA(At, 1, 1); PG8_STAGE(PG8_SB(1, 0), b3, voffB); PG8_STAGE(PG8_SB(1, 1), b3 + hstep, voffB); PG8_STAGE(PG8_SA(1, 0), a3, voffA);
            PG8_WAIT_V(8); PG8_WAIT_L(0); PG8_BAR; PG8_MMA(1, 0, At, B0); PG8_MMA(1, 1, At, B1); PG8_BAR; PG8_SCHED;
            } else {
            PG8_LDB(B0, 0, 0); PG8_SCHED; PG8_LDA(At, 0, 0); PG8_STAGE(PG8_SA(1, 1), a1 + hstep, voffA);
            PG8_WAIT_L(8); PG8_BAR; PG8_WAIT_L(0); PG8_MMA(0, 0, At, B0); PG8_BAR; PG8_SCHED;
            PG8_LDB(B1, 0, 1); PG8_STAGE(PG8_SB(0, 0), b2, voffB);
            PG8_BAR; PG8_WAIT_L(0); PG8_MMA(0, 1, At, B1); PG8_BAR;
            PG8_LDA(At, 0, 1); PG8_STAGE(PG8_SA(0, 0), a2, voffA);
            PG8_BAR; PG8_WAIT_L(0); PG8_MMA(1, 0, At, B0); PG8_BAR; PG8_SCHED;
            PG8_STAGE(PG8_SB(0, 1), b2 + hstep, voffB);
            PG8_WAIT_V(6); PG8_BAR; PG8_MMA(1, 1, At, B1); PG8_BAR;
            PG8_LDB(B0, 1, 0); PG8_SCHED; PG8_LDA(At, 1, 0); PG8_STAGE(PG8_SA(0, 1), a2 + hstep, voffA);
            PG8_WAIT_L(8); PG8_BAR; PG8_WAIT_L(0); PG8_MMA(0, 0, At, B0); PG8_BAR; PG8_SCHED;
            PG8_LDB(B1, 1, 1); PG8_STAGE(PG8_SB(1, 0), b3, voffB);
            PG8_BAR; PG8_WAIT_L(0); PG8_MMA(0, 1, At, B1); PG8_BAR;
            PG8_LDA(At, 1, 1); PG8_STAGE(PG8_SA(1, 0), a3, voffA);
            PG8_BAR; PG8_WAIT_L(0); PG8_MMA(1, 0, At, B0); PG8_BAR; PG8_SCHED;
            PG8_STAGE(PG8_SB(1, 1), b3 + hstep, voffB);
            PG8_WAIT_V(6); PG8_BAR; PG8_MMA(1, 1, At, B1); PG8_BAR;
            }
        }
        if constexpr (ALIGN_EPI) { if (wr == 0) PG8_BAR; }
        if constexpr (!Epi::AFTER_DRAIN) { E(acc, cur, wr, wc, fr, fq); S.done(cur); }
        if (!has_next) break;
#pragma unroll
        for (int a = 0; a < 2; ++a)
#pragma unroll
            for (int b = 0; b < 2; ++b)
#pragma unroll
                for (int m = 0; m < 4; ++m)
#pragma unroll
                    for (int n = 0; n < 2; ++n) acc[a][b][m][n] = (f32x4){0.f, 0.f, 0.f, 0.f};
        cur = nxt; cA = nA; cB = nB; ++ui;
        if constexpr (ALIGN_EPI) { if (wr == 1) PG8_BAR; }
    }
    PG8_WAIT_V(0);
    if constexpr (!ALIGN_EPI) { if (wr == 0) PG8_BAR; }
    PG8_BAR;
    if constexpr (Epi::AFTER_DRAIN) { E.fused(acc, cur, wr, wc, fr, fq, lds, wid, lane); S.done(cur); }
#undef PG8_SA
#undef PG8_SB
#undef PG8_STAGE
#undef PG8_LDA
#undef PG8_LDB
#undef PG8_MMA
#undef PG8_WAIT_V
#undef PG8_WAIT_L
#undef PG8_BAR
#undef PG8_SCHED
}
}
typedef unsigned short bf16_t;
typedef short bf16x8 __attribute__((ext_vector_type(8)));
typedef short s16x4 __attribute__((ext_vector_type(4)));
typedef float f32x4 __attribute__((ext_vector_type(4)));
typedef float f32x16 __attribute__((ext_vector_type(16)));
typedef unsigned u32x4 __attribute__((ext_vector_type(4)));
typedef unsigned u32x2 __attribute__((ext_vector_type(2)));
typedef unsigned long long u64;
#define DI __device__ __forceinline__
#define MFMA32(a, b, c) __builtin_amdgcn_mfma_f32_32x32x16_bf16((a), (b), (c), 0, 0, 0)
#define LDS_WAIT() asm volatile("s_waitcnt lgkmcnt(0)" ::: "memory")

constexpr int NB = 8, S = 4096, DM = 1024, T = NB * S, FF = 4096, NMEM = 256;
constexpr int PROJ_LD = 2304, QKV1_LD = 2816, NCMP = 255, CMP_ROWS = 6120, CMP_ROWS_PAD = 6144;
constexpr float EPS = 1e-6f;
constexpr float SC2 = 0.125f * 1.4426950408889634f;
constexpr size_t MiB = 1u << 20;
constexpr size_t WS_WAIN = 0, WS_WAOUT = 5 * MiB, WS_WUP = 7 * MiB, WS_WDN = 23 * MiB, WS_WMKV = 39 * MiB, WS_WKVB = 41 * MiB, WS_WBOUT = 47 * MiB, WS_WC1 = 49 * MiB;
constexpr size_t WS_PARAMS = 51 * MiB + 32768, WS_FLAG = 51 * MiB + 32768 + 1024, WS_B1P = 51 * MiB, WS_B1PART = 51 * MiB + 65536, WS_ROPE = 52 * MiB, WS_MEMN = 53 * MiB, WS_MEMKV = 57 * MiB, WS_MEMVF = 61 * MiB, WS_HID = 63 * MiB;
constexpr size_t WS_KCF = 69 * MiB, WS_VCF = 70 * MiB, WS_GATES = 71 * MiB, WS_MEMKF = 76 * MiB;
constexpr size_t WS_H = 80 * MiB, WS_VF1 = 80 * MiB, WS_VF4 = 112 * MiB;
constexpr size_t WS_TB = 144 * MiB, WS_VF16 = 144 * MiB, WS_KF1 = 176 * MiB;
constexpr size_t WS_R1 = 208 * MiB, WS_PROJ0 = WS_R1, WS_ATT0 = WS_R1 + 144 * MiB, WS_VSELF = WS_R1 + 208 * MiB, WS_VWINF = WS_R1 + 220 * MiB, WS_KSELF = WS_R1 + 232 * MiB, WS_KWINF = WS_R1 + 244 * MiB;
constexpr size_t WS_U = WS_R1, WS_QKV1 = WS_R1, WS_ATT1 = WS_R1 + 176 * MiB, WS_KF4 = 432 * MiB, WS_KF16 = 464 * MiB, WS_END = 496 * MiB;
constexpr int LDS_BYTES = 147456, LDS_MISC = 147392;
constexpr size_t WS_BAR = 51 * MiB + 131072, BAR_BYTES = 16384, WS_RSS = 51 * MiB + 262144;

struct Params {
    const float *x, *mem, *attn_norm, *mlp_norm, *w_up, *w_down, *mem_norm, *w_mem_kv, *mem_q_norm, *mem_k_norm,
        *a_w_in, *a_w_out, *a_q_norm, *a_k_norm, *a_cmp_pos, *a_cmp_w1, *a_cmp_b1, *a_cmp_w2, *a_cmp_b2,
        *kv_norm, *w_kv_shared, *kv_k_norm, *b_w_in, *b_w_out, *b_q_norm;
    float* out; unsigned char* ws;
};

DI unsigned f2bf(float f) { unsigned u = __builtin_bit_cast(unsigned, f); return (u + 0x7fffu + ((u >> 16) & 1u)) >> 16; }
DI unsigned pk2(float lo, float hi) { return f2bf(lo) | (f2bf(hi) << 16); }
DI float bflo(unsigned u) { return __builtin_bit_cast(float, u << 16); }
DI float bfhi(unsigned u) { return __builtin_bit_cast(float, u & 0xffff0000u); }
DI float bf2f(bf16_t b) { return __builtin_bit_cast(float, (unsigned)b << 16); }
DI float wave_sum(float v) {
#pragma unroll
    for (int o = 1; o < 64; o <<= 1) v += __shfl_xor(v, o);
    return v;
}
DI int crow(int reg, int h) { return (reg & 3) + 8 * (reg >> 2) + 4 * h; }
DI f32x16 zero16() { f32x16 z; for (int i = 0; i < 16; ++i) z[i] = 0.f; return z; }
DI bf16x8 pack8(const f32x16& x, int s) {
    u32x4 p;
#pragma unroll
    for (int j = 0; j < 4; ++j) p[j] = pg8::cvt_pk_bf16(x[8 * s + 2 * j], x[8 * s + 2 * j + 1]);
    return __builtin_bit_cast(bf16x8, p);
}

DI void wt_item(const float* W, int K, int N, int nblk, const float* gain, bf16_t* WT, int row_off, float* scr, int item, int lane) {
    const int kb = item / nblk, nb = item % nblk, k0 = 64 * kb, n0 = 32 * nb;
    const int n4 = n0 + (lane & 7) * 4;
    f32x4 v[8];
#pragma unroll
    for (int i = 0; i < 8; ++i) { const int kk = i * 8 + (lane >> 3);
        v[i] = (n4 < N) ? *(const __attribute__((address_space(1))) f32x4*)(W + (size_t)(k0 + kk) * N + n4) : (f32x4){0.f, 0.f, 0.f, 0.f}; }
#pragma unroll
    for (int i = 0; i < 8; ++i) { const int kk = i * 8 + (lane >> 3); f32x4 t = v[i]; if (gain) t = t * gain[k0 + kk];
        float* d = scr + kk * 33 + (lane & 7) * 4; d[0] = t.x; d[1] = t.y; d[2] = t.z; d[3] = t.w; }
    LDS_WAIT();
    const int c = lane & 7;
#pragma unroll
    for (int j = 0; j < 4; ++j) { const int n = (lane >> 3) + 8 * j; const float* s = scr + (8 * c) * 33 + n;
        u32x4 o; o.x = pk2(s[0 * 33], s[1 * 33]); o.y = pk2(s[2 * 33], s[3 * 33]); o.z = pk2(s[4 * 33], s[5 * 33]); o.w = pk2(s[6 * 33], s[7 * 33]);
        *(__attribute__((address_space(1))) u32x4*)(WT + (size_t)(row_off + n0 + n) * K + k0 + 8 * c) = o; }
    LDS_WAIT();
}
DI void rms_row_to_bf16(const float* xrow, bf16_t* orow, int lane) {
    const f32x4* xr = (const f32x4*)xrow + lane;
    f32x4 v[4]; float s = 0.f;
#pragma unroll
    for (int j = 0; j < 4; ++j) { v[j] = xr[64 * j]; s += (v[j].x * v[j].x + v[j].y * v[j].y) + (v[j].z * v[j].z + v[j].w * v[j].w); }
    const float rstd = 1.0f / sqrtf(wave_sum(s) * (1.f / DM) + EPS);
    u64* o8 = (u64*)orow + lane;
#pragma unroll
    for (int j = 0; j < 4; ++j) o8[64 * j] = (u64)pk2(v[j].x * rstd, v[j].y * rstd) | ((u64)pk2(v[j].z * rstd, v[j].w * rstd) << 32);
}
DI void norm_rows(const float* src, bf16_t* dst, int nrows, int gw, int NGW, int lane) {
    for (int m = gw; m < nrows; m += NGW) rms_row_to_bf16(src + (size_t)m * DM, dst + (size_t)m * DM, lane);
}

DI void prep_weights_a(const Params& p, unsigned char* smem, int gw, int NGW, int wave, int lane) {
    unsigned char* ws = p.ws;
    float* scr = (float*)(smem + wave * 8704);
    constexpr int I_AIN = 16 * 72, I_MKV = 16 * 16, I_C1 = 32 * 8;
    constexpr int NITEMS = I_AIN + 2 * I_MKV + 2 * I_C1;
    for (int it = gw; it < NITEMS; it += NGW) {
        int r = it;
        if (r < I_AIN) { wt_item(p.a_w_in, 1024, 2212, 72, p.attn_norm, (bf16_t*)(ws + WS_WAIN), 0, scr, r, lane); continue; } r -= I_AIN;
        if (r < 2 * I_MKV) { const int l = r / I_MKV; wt_item(p.w_mem_kv + (size_t)l * DM * 512, 1024, 512, 16, p.mem_norm + l * DM, (bf16_t*)(ws + WS_WMKV), l * 512, scr, r % I_MKV, lane); continue; } r -= 2 * I_MKV;
        { const int i = r / I_C1; wt_item(p.a_cmp_w1 + (size_t)i * 2048 * 256, 2048, 256, 8, nullptr, (bf16_t*)(ws + WS_WC1) + (size_t)i * 2048 * 256, 0, scr, r % I_C1, lane); }
    }
}
DI void prep_weights_b(const Params& p, unsigned char* smem, int gw, int NGW, int wave, int lane) {
    unsigned char* ws = p.ws;
    float* scr = (float*)(smem + wave * 8704);
    constexpr int I_AOUT = 16 * 32, I_UP = 16 * 128, I_DN = 64 * 32, I_KVS = 16 * 32, I_BIN = 16 * 56, I_BOUT = 12 * 32;
    constexpr int NITEMS = I_AOUT + 2 * I_UP + 2 * I_DN + I_KVS + I_BIN + I_BOUT;
    for (int it = gw; it < NITEMS; it += NGW) {
        int r = it;
        if (r < I_AOUT) { wt_item(p.a_w_out, 1024, 1024, 32, nullptr, (bf16_t*)(ws + WS_WAOUT), 0, scr, r, lane); continue; } r -= I_AOUT;
        if (r < 2 * I_UP) { const int l = r / I_UP; wt_item(p.w_up + (size_t)l * DM * FF, 1024, 4096, 128, p.mlp_norm + l * DM, (bf16_t*)(ws + WS_WUP) + (size_t)l * DM * FF, 0, scr, r % I_UP, lane); continue; } r -= 2 * I_UP;
        if (r < 2 * I_DN) { const int l = r / I_DN; wt_item(p.w_down + (size_t)l * DM * FF, 4096, 1024, 32, nullptr, (bf16_t*)(ws + WS_WDN) + (size_t)l * DM * FF, 0, scr, r % I_DN, lane); continue; } r -= 2 * I_DN;
        if (r < I_KVS) { wt_item(p.w_kv_shared, 1024, 1024, 32, p.kv_norm, (bf16_t*)(ws + WS_WKVB), 0, scr, r, lane); continue; } r -= I_KVS;
        if (r < I_BIN) { wt_item(p.b_w_in, 1024, 1792, 56, p.attn_norm + DM, (bf16_t*)(ws + WS_WKVB), 1024, scr, r, lane); continue; } r -= I_BIN;
        wt_item(p.b_w_out, 768, 1024, 32, nullptr, (bf16_t*)(ws + WS_WBOUT), 0, scr, r, lane);
    }
}
DI void phase_prep(const Params& p, unsigned char* smem, int gw, int NGW, int wave, int lane) {
    unsigned char* ws = p.ws;
    prep_weights_a(p, smem, gw, NGW, wave, lane);
    norm_rows(p.x, (bf16_t*)(ws + WS_H), T, gw, NGW, lane);
    norm_rows(p.mem, (bf16_t*)(ws + WS_MEMN), NB * NMEM, gw, NGW, lane);
    const int gtid = gw * 64 + lane, NT = NGW * 64;
    for (int idx = gtid; idx < 3 * T; idx += NT) ((float*)(ws + WS_RSS))[idx] = 0.f;
    float* rope = (float*)(ws + WS_ROPE);
    for (int idx = gtid; idx < S * 32; idx += NT) {
        const int pos = idx >> 5, fi = idx & 31;
        const float inv = powf(10000.0f, -(float)fi / 32.0f);
        const float ang = (float)pos * inv;
        const double ad = (double)ang; const double k = rint(ad * 0.15915494309189535); const float rr = (float)(ad - k * 6.283185307179586);
        rope[2 * idx] = cosf(rr); rope[2 * idx + 1] = sinf(rr);
    }
    if (gtid == 0) {
        auto mx = [](const float* w) { float m = 0.f; for (int i = 0; i < 64; ++i) m = fmaxf(m, fabsf(w[i])); return m; };
        const float aq = mx(p.a_q_norm), kvk = mx(p.kv_k_norm);
        float worst = fmaxf(aq * mx(p.a_k_norm + 64), aq * mx(p.a_k_norm + 128));
        worst = fmaxf(worst, fmaxf(mx(p.mem_q_norm) * mx(p.mem_k_norm), mx(p.mem_q_norm + 64) * mx(p.mem_k_norm + 64)));
        worst = fmaxf(worst, kvk * fmaxf(mx(p.b_q_norm), fmaxf(mx(p.b_q_norm + 64), mx(p.b_q_norm + 128))));
        *(int*)(ws + WS_FLAG) = (64.0f * SC2 * 1.03f * worst <= 60.0f) ? 1 : 0;
    }
    float* part = (float*)(ws + WS_B1PART);
    for (int idx = gtid; idx < 16 * 512; idx += NT) {
        const int kc = idx >> 9, in = idx & 511, i = in >> 8, n = in & 255;
        const float* w1 = p.a_cmp_w1 + (size_t)i * 2048 * 256 + (size_t)(kc * 128) * 256 + n; const float* ps = p.a_cmp_pos + i * 2048 + kc * 128;
        float a = 0.f;
        for (int k = 0; k < 128; ++k) a += ps[k] * w1[(size_t)k * 256];
        part[idx] = a;
    }
}
#define LAS __attribute__((address_space(3)))
#define XB_TMO      128
#define XB_XCNT(j)  (256  + 64 * (j))
#define XB_XSUB(j)  (1280 + 64 * (j))
#define XB_XGEN(j)  (2304 + 64 * (j))
#define XB_TOP      3328
#define XB_TOPGEN   3392
#define XCD_BAR_WORDS 3456
#define XB_SPIN_CAP (1u << 18)

__device__ __forceinline__ unsigned xb_ld(unsigned* p)              { return __hip_atomic_load(p, __ATOMIC_RELAXED, __HIP_MEMORY_SCOPE_AGENT); }
__device__ __forceinline__ unsigned xb_add(unsigned* p, unsigned v) { return __hip_atomic_fetch_add(p, v, __ATOMIC_RELAXED, __HIP_MEMORY_SCOPE_AGENT); }
__device__ __forceinline__ unsigned xb_xcc_id() { return (unsigned)__builtin_amdgcn_s_getreg((3 << 11) | 20) & 0xFu; }
#define XB_SPIN(cond, bar) do { unsigned _sp = 0; while (cond) { __builtin_amdgcn_s_sleep(1); \
    if ((++_sp & 255u) == 0u) { if (xb_ld(&(bar)[XB_TMO])) break; if (_sp > XB_SPIN_CAP) { atomicAdd(&(bar)[XB_TMO], 1u); break; } } } } while (0)

struct XcdBarrier {
    unsigned* bar; unsigned x;
    volatile LAS unsigned* st;
};

__device__ __forceinline__ XcdBarrier xcd_barrier_post(unsigned* bar, volatile LAS unsigned* st) {
    XcdBarrier b; b.bar = bar; b.x = xb_xcc_id(); b.st = st;
    if (threadIdx.x == 0) (void)xb_add(&bar[XB_XCNT(b.x)], 1u);
    return b;
}
__device__ __forceinline__ void xcd_barrier_complete(unsigned* bar, unsigned x, unsigned& nloc, unsigned& nx) {
    const unsigned G = gridDim.x * gridDim.y * gridDim.z;
    unsigned sum, cnt, mine, sp = 0u;
    for (;;) {
        sum = 0u; cnt = 0u; mine = 0u;
#pragma unroll
        for (unsigned j = 0; j < 16; ++j) { const unsigned c = xb_ld(&bar[XB_XCNT(j)]); sum += c; cnt += (c > 0u) ? 1u : 0u; mine = (j == x) ? c : mine; }
        if (sum == G) break;
        __builtin_amdgcn_s_sleep(1);
        if ((++sp & 255u) == 0u) { if (xb_ld(&bar[XB_TMO])) break; if (sp > XB_SPIN_CAP) { atomicAdd(&bar[XB_TMO], 1u); break; } }
    }
    nloc = mine > 0u ? mine : 1u; nx = cnt > 0u ? cnt : 1u;
}

__device__ __forceinline__ void xcd_barrier(const XcdBarrier& b) {
    asm volatile("s_waitcnt vmcnt(0)" ::: "memory");
    __syncthreads();
    if (threadIdx.x == 0) {
        unsigned* bar = b.bar;
        __builtin_amdgcn_s_waitcnt(0);
        unsigned nloc = b.st[0], nx = b.st[1];
        if (nloc == 0u) { xcd_barrier_complete(bar, b.x, nloc, nx); b.st[0] = nloc; b.st[1] = nx; }
        const unsigned old = xb_add(&bar[XB_XSUB(b.x)], 1u);
        const unsigned gen = old / nloc;
        if (old + 1u == (gen + 1u) * nloc) {
            __builtin_amdgcn_fence(__ATOMIC_RELEASE, "agent");
            asm volatile("s_waitcnt vmcnt(0)" ::: "memory");
            const unsigned og = xb_add(&bar[XB_TOP], 1u);
            const unsigned tg = og / nx;
            if (og + 1u == (tg + 1u) * nx) xb_add(&bar[XB_TOPGEN], 1u);
            else XB_SPIN(xb_ld(&bar[XB_TOPGEN]) == tg, bar);
            __builtin_amdgcn_fence(__ATOMIC_ACQUIRE, "agent");
            xb_add(&bar[XB_XGEN(b.x)], 1u);
            asm volatile("s_waitcnt vmcnt(0)" ::: "memory");
        } else {
            XB_SPIN(xb_ld(&bar[XB_XGEN(b.x)]) == gen, bar);
            __builtin_amdgcn_fence(__ATOMIC_ACQUIRE, "agent");
            asm volatile("s_waitcnt vmcnt(0)" ::: "memory");
        }
    }
    __syncthreads();
}

DI void unpack8(const u32x4& raw, float (&v)[8]) {
#pragma unroll
    for (int j = 0; j < 4; ++j) { v[2 * j] = bflo(raw[j]); v[2 * j + 1] = bfhi(raw[j]); }
}
DI u32x4 pack8f(const float (&v)[8]) { u32x4 o; for (int j = 0; j < 4; ++j) o[j] = pk2(v[2 * j], v[2 * j + 1]); return o; }
DI void seg_norm(float (&v)[8], const float* w, int sub, float qs) {
    float ss = 0.f;
#pragma unroll
    for (int e = 0; e < 8; ++e) ss += v[e] * v[e];
    ss += __builtin_bit_cast(float, __builtin_amdgcn_update_dpp(0, __builtin_bit_cast(int, ss), 0xB1, 0xF, 0xF, false));
    ss += __builtin_bit_cast(float, __builtin_amdgcn_update_dpp(0, __builtin_bit_cast(int, ss), 0x4E, 0xF, 0xF, false));
    ss += __builtin_bit_cast(float, __builtin_amdgcn_update_dpp(0, __builtin_bit_cast(int, ss), 0x141, 0xF, 0xF, false));
    const float rs = qs / sqrtf(ss * (1.f / 64.f) + EPS);
    const f32x4 w0 = *(const f32x4*)(w + sub * 8), w1 = *(const f32x4*)(w + sub * 8 + 4);
#pragma unroll
    for (int e = 0; e < 4; ++e) { v[e] = v[e] * rs * w0[e]; v[4 + e] = v[4 + e] * rs * w1[e]; }
}
DI void seg_rope(float (&v)[8], const float (&cs)[8], const float (&sn)[8], int sub) {
#pragma unroll
    for (int e = 0; e < 8; ++e) { const float py = __shfl_xor(v[e], 4); v[e] = (sub < 4) ? v[e] * cs[e] - py * sn[e] : py * sn[e] + v[e] * cs[e]; }
}
DI void load_rope(const float* rope, int pos, int sub, float (&cs)[8], float (&sn)[8]) {
    const f32x4* rp = (const f32x4*)(rope + ((size_t)pos * 32 + (sub & 3) * 8) * 2);
#pragma unroll
    for (int j = 0; j < 4; ++j) { const f32x4 t = rp[j]; cs[2 * j] = t.x; sn[2 * j] = t.y; cs[2 * j + 1] = t.z; sn[2 * j + 1] = t.w; }
}

DI size_t kfrag_off(int key, int sub) { return (size_t)(key >> 5) * 2048 + (sub * 32 + (key & 31)) * 8; }
#define GLD4(p) (*(const __attribute__((address_space(1))) u32x4*)(p))
#define GST4(p, v) (*(__attribute__((address_space(1))) u32x4*)(p) = (v))
DI bool post0_need(int seg) { return (seg >= 12 && seg < 21) || (seg >= 24 && seg < 27) || seg == 34; }
DI void post0_seg(const Params& p, const u32x4 raw, int seg, int token, int sub, const float (&cs)[8], const float (&sn)[8]) {
    unsigned char* ws = p.ws;
    const int s = token & (S - 1), b = token >> 12;
    bf16_t* ptr = (bf16_t*)(ws + WS_PROJ0) + (size_t)token * PROJ_LD + seg * 64 + sub * 8;
    float v[8]; unpack8(raw, v);
    if (seg == 34) {
        float* gp = (float*)(ws + WS_GATES) + (size_t)token * 36 + sub * 8;
#pragma unroll
        for (int e = 0; e < 8; ++e) if (sub * 8 + e < 36) gp[e] = 1.0f / (1.0f + __expf(-v[e]));
        return;
    }
    if (seg >= 12 && seg < 18) {
        const int i = (seg - 12) / 3, g = (seg - 12) % 3;
        bf16_t* tb = (bf16_t*)(ws + WS_TB) + (size_t)i * CMP_ROWS_PAD * 2048;
        const int c1 = s >> 4, j1 = s & 15; const size_t rb = (size_t)(b * 3 + g) * NCMP;
        if (c1 <= 254) GST4(tb + (rb + c1) * 2048 + j1 * 64 + sub * 8, raw);
        if (c1 >= 1) GST4(tb + (rb + c1 - 1) * 2048 + (j1 + 16) * 64 + sub * 8, raw);
        return;
    }
    const float* w = p.a_q_norm; float qs = 1.0f;
    if (seg < 12) qs = SC2;
    else if (seg < 21) w = p.a_k_norm + 64;
    else if (seg < 27) w = p.a_k_norm + 128;
    else { w = p.mem_q_norm; qs = SC2; }
    seg_norm(v, w, sub, qs);
    if (seg >= 30) { GST4(ptr, pack8f(v)); return; }
    seg_rope(v, cs, sn, sub);
    if (seg < 12) GST4(ptr, pack8f(v));
    else { const int g = (seg - 18) % 6, which = (seg - 18) / 6;
        bf16_t* kf = (bf16_t*)(ws + (which ? WS_KWINF : WS_KSELF)) + (size_t)(b * 3 + g) * S * 64;
        GST4(kf + kfrag_off(s, sub), pack8f(v)); }
}
DI bool post1_need(int seg) { return seg < 8; }
DI void post1_seg(const Params& p, const u32x4 raw, int seg, int token, int sub, const float (&cs)[8], const float (&sn)[8]) {
    unsigned char* ws = p.ws;
    const int s = token & (S - 1);
    bf16_t* ptr = (bf16_t*)(ws + WS_QKV1) + (size_t)token * QKV1_LD + seg * 64 + sub * 8;
    float v[8]; unpack8(raw, v);
    const float* w = p.kv_k_norm; float qs = 1.0f;
    if (seg >= 40) { w = p.mem_q_norm + 64; qs = SC2; }
    else if (seg >= 16) { w = p.b_q_norm + ((seg - 16) >> 3) * 64; qs = SC2; }
    seg_norm(v, w, sub, qs);
    if (seg >= 40) { GST4(ptr, pack8f(v)); return; }
    seg_rope(v, cs, sn, sub);
    const u32x4 o = pack8f(v);
    if (seg >= 16) GST4(ptr, o);
    else {
        const size_t hb = (size_t)((token >> 12) * 8 + seg) * S * 64;
        GST4((bf16_t*)(ws + WS_KF1) + hb + kfrag_off(s, sub), o);
        GST4((bf16_t*)(ws + WS_KF4) + hb + (size_t)(s & 3) * (S / 4) * 64 + kfrag_off(s >> 2, sub), o);
        GST4((bf16_t*)(ws + WS_KF16) + hb + (size_t)(s & 15) * (S / 16) * 64 + kfrag_off(s >> 4, sub), o);
    }
}
template <int LAYER>
DI void post_rows(const Params& p, int gw, int NGW, int lane) {
    unsigned char* ws = p.ws;
    constexpr int NSEG = LAYER == 0 ? 36 : 44, LD = LAYER == 0 ? PROJ_LD : QKV1_LD, NCH = NSEG / 4;
    const int sub = lane & 7, tl = lane >> 3;
    for (int g8 = gw; g8 < T / 8; g8 += NGW) {
        const int token = g8 * 8 + tl;
        const bf16_t* rowl = (const bf16_t*)(ws + (LAYER == 0 ? WS_PROJ0 : WS_QKV1)) + (size_t)token * LD + sub * 8;
        float cs[8], sn[8]; load_rope((const float*)(ws + WS_ROPE), token & (S - 1), sub, cs, sn);
        u32x4 ra[4], rb[4];
#pragma unroll
        for (int j = 0; j < 4; ++j) if (LAYER == 0 ? post0_need(j) : post1_need(j)) ra[j] = GLD4(rowl + j * 64);
#pragma unroll 1
        for (int c = 0; c < NCH; c += 2) {
            if (c + 1 < NCH) {
#pragma unroll
                for (int j = 0; j < 4; ++j) { const int seg = (c + 1) * 4 + j; if (LAYER == 0 ? post0_need(seg) : post1_need(seg)) rb[j] = GLD4(rowl + seg * 64); }
            }
#pragma unroll
            for (int j = 0; j < 4; ++j) { const int seg = c * 4 + j; if (LAYER == 0) { if (post0_need(seg)) post0_seg(p, ra[j], seg, token, sub, cs, sn); } else { if (post1_need(seg)) post1_seg(p, ra[j], seg, token, sub, cs, sn); } }
            if (c + 1 >= NCH) break;
            if (c + 2 < NCH) {
#pragma unroll
                for (int j = 0; j < 4; ++j) { const int seg = (c + 2) * 4 + j; if (LAYER == 0 ? post0_need(seg) : post1_need(seg)) ra[j] = GLD4(rowl + seg * 64); }
            }
#pragma unroll
            for (int j = 0; j < 4; ++j) { const int seg = (c + 1) * 4 + j; if (LAYER == 0) { if (post0_need(seg)) post0_seg(p, rb[j], seg, token, sub, cs, sn); } else { if (post1_need(seg)) post1_seg(p, rb[j], seg, token, sub, cs, sn); } }
        }
    }
}
DI void memk_row(const Params& p, int m, int lane) {
    bf16_t* row = (bf16_t*)(p.ws + WS_MEMKV) + (size_t)m * 1024;
    const int sub = lane & 7, sgl = lane >> 3, l = sgl >> 2, mh = sgl & 3;
    bf16_t* ptr = row + l * 512 + mh * 64 + sub * 8;
    const u32x4 raw = *(const u32x4*)ptr; float v[8]; unpack8(raw, v);
    seg_norm(v, p.mem_k_norm + l * 64, sub, 1.0f);
    bf16_t* kf = (bf16_t*)(p.ws + WS_MEMKF) + (size_t)((l * 8 + (m >> 8)) * 4 + mh) * NMEM * 64;
    *(u32x4*)(kf + kfrag_off(m & 255, sub)) = pack8f(v);
}
DI void vf_load(u32x4 (&v)[8], const bf16_t* src, size_t src_rs, int lane) {
    const int sub = lane & 7, rr = lane >> 3;
#pragma unroll
    for (int i = 0; i < 8; ++i) v[i] = GLD4(src + (size_t)(i * 8 + rr) * src_rs + sub * 8);
}
DI void vf_proc(const u32x4 (&v)[8], bf16_t* dst, bf16_t* scr, int lane) {
    const int sub = lane & 7, rr = lane >> 3;
#pragma unroll
    for (int i = 0; i < 8; ++i) { const int rw = i * 8 + rr; unsigned* d = (unsigned*)(scr + rw * 66 + sub * 8); d[0] = v[i].x; d[1] = v[i].y; d[2] = v[i].z; d[3] = v[i].w; }
    LDS_WAIT();
    const int h = lane >> 5, r = lane & 31;
#pragma unroll
    for (int i = 0; i < 8; ++i) { const int blk = i & 1, si = (i >> 1) & 1, tl = i >> 2;
        const bf16_t* sp = scr + (tl * 32 + 16 * si + 4 * h) * 66 + 32 * blk + r;
        u32x4 o;
#pragma unroll
        for (int j2 = 0; j2 < 4; ++j2) { const int k0 = 8 * (j2 >> 1) + 2 * (j2 & 1); o[j2] = (unsigned)sp[k0 * 66] | ((unsigned)sp[(k0 + 1) * 66] << 16); }
        GST4(dst + (size_t)(i * 64 + lane) * 8, o); }
    LDS_WAIT();
}
DI void vf_item(const bf16_t* src, size_t src_rs, bf16_t* dst, bf16_t* scr, int lane) { u32x4 v[8]; vf_load(v, src, src_rs, lane); vf_proc(v, dst, scr, lane); }

DI void phase_post0(const Params& p, unsigned char* smem, int gw, int NGW, int wave, int lane) {
    unsigned char* ws = p.ws;
    post_rows<0>(p, gw, NGW, lane);
    bf16_t* scr = (bf16_t*)(smem + wave * 8704);
    for (int it = gw; it < 2 * 24 * 64; it += NGW) {
        const int which = it / (24 * 64), bg = (it / 64) % 24, ti = it % 64, b = bg / 3, g = bg % 3;
        const bf16_t* src = (const bf16_t*)(ws + WS_PROJ0) + ((size_t)b * S + ti * 64) * PROJ_LD + (which ? 1728 : 1344) + g * 64;
        bf16_t* dst = (bf16_t*)(ws + (which ? WS_VWINF : WS_VSELF)) + (size_t)bg * 64 * S + (size_t)ti * 4096;
        vf_item(src, PROJ_LD, dst, scr, lane);
    }
    const int gtid = gw * 64 + lane;
    if (gtid < 512) { const float* part = (const float*)(ws + WS_B1PART); float a = p.a_cmp_b1[gtid];
        for (int kc = 0; kc < 16; ++kc) a += part[kc * 512 + gtid];
        ((float*)(ws + WS_B1P))[gtid] = a; }
}
DI void phase_mempost(const Params& p, unsigned char* smem, int gw, int NGW, int wave, int lane) {
    unsigned char* ws = p.ws;
    for (int m = gw; m < NB * NMEM; m += NGW) memk_row(p, m, lane);
    bf16_t* scr = (bf16_t*)(smem + wave * 8704);
    for (int it = gw; it < 2 * 8 * 4 * 4; it += NGW) {
        const int ti = it & 3, mh = (it >> 2) & 3, b = (it >> 4) & 7, l = it >> 7;
        const bf16_t* src = (const bf16_t*)(ws + WS_MEMKV) + ((size_t)b * NMEM + ti * 64) * 1024 + l * 512 + 256 + mh * 64;
        bf16_t* dst = (bf16_t*)(ws + WS_MEMVF) + (size_t)((l * 8 + b) * 4 + mh) * 64 * NMEM + (size_t)ti * 4096;
        vf_item(src, 1024, dst, scr, lane);
    }
}
DI void phase_post1(const Params& p, unsigned char* smem, int gw, int NGW, int wave, int lane) {
    unsigned char* ws = p.ws;
    post_rows<1>(p, gw, NGW, lane);
    bf16_t* scr = (bf16_t*)(smem + wave * 8704);
    auto geo = [&](int it, const bf16_t*& src, size_t& rs, bf16_t*& dst) {
        const int gi = it / 4096, bh = (it / 64) % 64, q = it % 64, b = bh >> 3, hs = bh & 7;
        const int dil = gi == 0 ? 1 : (gi == 1 ? 4 : 16), clen = S / dil, tpc = clen / 64, rc = q / tpc, ti = q % tpc;
        src = (const bf16_t*)(ws + WS_QKV1) + ((size_t)b * S + rc + (size_t)dil * ti * 64) * QKV1_LD + 512 + hs * 64;
        dst = (bf16_t*)(ws + (gi == 0 ? WS_VF1 : (gi == 1 ? WS_VF4 : WS_VF16))) + (size_t)bh * 64 * S + ((size_t)rc * clen + ti * 64) * 64;
        rs = (size_t)dil * QKV1_LD; };
    if (gw < 3 * 64 * 64) {
        u32x4 va[8], vb[8]; const bf16_t* src; size_t rs; bf16_t* dst; int it = gw;
        geo(it, src, rs, dst); vf_load(va, src, rs, lane);
        for (;;) {
            const int nit = it + NGW; const bool hn = nit < 3 * 64 * 64;
            const bf16_t* nsrc = src; size_t nrs = rs; bf16_t* ndst = dst;
            if (hn) { geo(nit, nsrc, nrs, ndst); vf_load(vb, nsrc, nrs, lane); }
            vf_proc(va, dst, scr, lane);
            if (!hn) break;
#pragma unroll
            for (int i = 0; i < 8; ++i) va[i] = vb[i];
            it = nit; dst = ndst; src = nsrc; rs = nrs;
        }
    }
}
DI size_t vfrag_off(int key, int d) { const int kk = key & 31, si = kk >> 4, q = kk & 15, j = (q >> 3) * 4 + (q & 3), h = (q >> 2) & 1;
    return (size_t)(key >> 5) * 2048 + ((((si * 2 + (d >> 5)) * 2 + h) * 32 + (d & 31)) * 8 + j); }
DI void phase_cmp2(const Params& p, int gw, int NGW, int lane) {
    unsigned char* ws = p.ws;
    for (int it = gw; it < 2 * CMP_ROWS; it += NGW) {
        const int i = __builtin_amdgcn_readfirstlane(it / CMP_ROWS), rowi = __builtin_amdgcn_readfirstlane(it % CMP_ROWS);
        const int bg = rowi / NCMP, c = rowi % NCMP;
        const unsigned* hid = (const unsigned*)((const bf16_t*)(ws + WS_HID) + ((size_t)i * CMP_ROWS_PAD + rowi) * 256);
        const float* w2 = p.a_cmp_w2 + (size_t)i * 256 * 64 + lane;
        float acc = p.a_cmp_b2[i * 64 + lane], acc1 = 0.f, acc2 = 0.f, acc3 = 0.f;
#pragma unroll 4
        for (int k2 = 0; k2 < 128; k2 += 2) { const unsigned hv = hid[k2], hw = hid[k2 + 1];
            acc += bflo(hv) * w2[(2 * k2) * 64]; acc1 += bfhi(hv) * w2[(2 * k2 + 1) * 64];
            acc2 += bflo(hw) * w2[(2 * k2 + 2) * 64]; acc3 += bfhi(hw) * w2[(2 * k2 + 3) * 64]; }
        acc = (acc + acc1) + (acc2 + acc3);
        if (i == 0) {
            const float ss = wave_sum(acc * acc);
            float y = acc * (1.0f / sqrtf(ss * (1.f / 64.f) + EPS)) * p.a_k_norm[lane];
            const float* rp = (const float*)(ws + WS_ROPE) + ((size_t)(c * 16 + 31) * 32 + (lane & 31)) * 2;
            const float py = __shfl_xor(y, 32);
            y = (lane < 32) ? y * rp[0] - py * rp[1] : py * rp[1] + y * rp[0];
            bf16_t* kc = (bf16_t*)(ws + WS_KCF) + (size_t)bg * 256 * 64;
            kc[kfrag_off(c, lane >> 3) + (lane & 7)] = (bf16_t)f2bf(y);
            if (c == NCMP - 1) kc[kfrag_off(255, lane >> 3) + (lane & 7)] = 0;
        } else {
            bf16_t* vcf = (bf16_t*)(ws + WS_VCF) + (size_t)bg * 64 * 256;
            vcf[vfrag_off(c, lane)] = (bf16_t)f2bf(acc);
            if (c == NCMP - 1) vcf[vfrag_off(255, lane)] = 0;
        }
    }
}
struct Tile { int ko; int vo; int aux; };
#define GLD8(p) (*(const __attribute__((address_space(1))) bf16x8*)(p))
DI float rowmax16(const f32x16& s) {
    float r, t1, t2, t3, t4;
    asm("s_nop 7\n\ts_nop 7\n\t"
        "v_max3_f32 %0, %5, %6, %7\n\tv_max3_f32 %1, %8, %9, %10\n\tv_max3_f32 %2, %11, %12, %13\n\tv_max3_f32 %3, %14, %15, %16\n\tv_max3_f32 %4, %17, %18, %19\n\t"
        "v_max3_f32 %0, %0, %1, %2\n\tv_max3_f32 %3, %3, %4, %20\n\tv_max_f32 %0, %0, %3"
        : "=&v"(r), "=&v"(t1), "=&v"(t2), "=&v"(t3), "=&v"(t4)
        : "v"(s[0]), "v"(s[1]), "v"(s[2]), "v"(s[3]), "v"(s[4]), "v"(s[5]), "v"(s[6]), "v"(s[7]), "v"(s[8]), "v"(s[9]), "v"(s[10]), "v"(s[11]), "v"(s[12]), "v"(s[13]), "v"(s[14]), "v"(s[15]));
    return r;
}
template <bool FAST> struct FSx { float m, l; f32x16 o0, o1; static constexpr bool fast = FAST; };
template <class ST> DI void fs_init(ST& st) { st.m = ST::fast ? 0.f : -1e30f; st.l = 0.f; st.o0 = zero16(); st.o1 = zero16(); }
DI void load_q(bf16x8 (&qf)[4], const bf16_t* qrow, int h) {
#pragma unroll
    for (int ks = 0; ks < 4; ++ks) qf[ks] = GLD8(qrow + 16 * ks + 8 * h);
}
template <bool ROPE>
DI void load_q_norm(bf16x8 (&qf)[4], const bf16_t* qrow, const float* w, const float* rope_row, int h) {
    float v[4][8];
#pragma unroll
    for (int ks = 0; ks < 4; ++ks) { const u32x4 raw = *(const __attribute__((address_space(1))) u32x4*)(qrow + 16 * ks + 8 * h);
#pragma unroll
        for (int jj = 0; jj < 4; ++jj) { v[ks][2 * jj] = bflo(raw[jj]); v[ks][2 * jj + 1] = bfhi(raw[jj]); } }
    float ss = 0.f;
#pragma unroll
    for (int ks = 0; ks < 4; ++ks)
#pragma unroll
        for (int e = 0; e < 8; ++e) ss += v[ks][e] * v[ks][e];
    ss += __shfl_xor(ss, 32);
    const float rs = SC2 / sqrtf(ss * (1.f / 64.f) + EPS);
#pragma unroll
    for (int ks = 0; ks < 4; ++ks) { const f32x4 w0 = *(const f32x4*)(w + 16 * ks + 8 * h), w1 = *(const f32x4*)(w + 16 * ks + 8 * h + 4);
#pragma unroll
        for (int e = 0; e < 4; ++e) { v[ks][e] *= rs * w0[e]; v[ks][4 + e] *= rs * w1[e]; } }
    if (ROPE) {
#pragma unroll
        for (int hf = 0; hf < 2; ++hf) { const f32x4* rp = (const f32x4*)(rope_row + 2 * (16 * hf + 8 * h));
#pragma unroll
            for (int jj = 0; jj < 4; ++jj) { const f32x4 cs = rp[jj];
                { const float x1 = v[hf][2 * jj], x2 = v[hf + 2][2 * jj]; v[hf][2 * jj] = x1 * cs.x - x2 * cs.y; v[hf + 2][2 * jj] = x1 * cs.y + x2 * cs.x; }
                { const float x1 = v[hf][2 * jj + 1], x2 = v[hf + 2][2 * jj + 1]; v[hf][2 * jj + 1] = x1 * cs.z - x2 * cs.w; v[hf + 2][2 * jj + 1] = x1 * cs.w + x2 * cs.z; } } }
    }
#pragma unroll
    for (int ks = 0; ks < 4; ++ks) qf[ks] = __builtin_bit_cast(bf16x8, pack8f(v[ks]));
}
typedef float f32x2 __attribute__((ext_vector_type(2)));
template <class ST, class Mask>
DI void attend_tile(ST& st, const bf16x8 (&qf)[4], const bf16x8 (&kf)[4], const bf16x8 (&vf)[4], Mask& mask, int aux, int h) {
    f32x16 s = zero16();
#pragma unroll
    for (int ks = 0; ks < 4; ++ks) s = MFMA32(kf[ks], qf[ks], s);
    if (!mask.full(aux)) {
        const int d = mask.prep(aux);
#pragma unroll
        for (int i = 0; i < 16; ++i) s[i] = mask.elem(d, (i & 3) + 8 * (i >> 2)) ? s[i] : -INFINITY;
    }
    const bool on = mask.lane(aux);
    if constexpr (ST::fast) {
        f32x2 acc2 = {0.f, 0.f};
#pragma unroll
        for (int i = 0; i < 8; ++i) { f32x2 v; v.x = __builtin_amdgcn_exp2f(s[2 * i]); v.y = __builtin_amdgcn_exp2f(s[2 * i + 1]); s[2 * i] = v.x; s[2 * i + 1] = v.y; acc2 = acc2 + v; }
        st.l += on ? (acc2.x + acc2.y) : 0.f;
        const unsigned onm = on ? 0xffffffffu : 0u;
#pragma unroll
        for (int si = 0; si < 2; ++si) {
            u32x4 w = __builtin_bit_cast(u32x4, pack8(s, si)); w = w & onm;
            const bf16x8 pb = __builtin_bit_cast(bf16x8, w);
            st.o0 = MFMA32(vf[si * 2], pb, st.o0);
            st.o1 = MFMA32(vf[si * 2 + 1], pb, st.o1);
        }
        return;
    }
    float mx = rowmax16(s);
    mx = on ? mx : -INFINITY;
    if (__any(mx > st.m + 6.0f)) {
        mx = fmaxf(mx, __shfl_xor(mx, 32));
        const float mn = fmaxf(st.m, mx);
        const float alpha = __builtin_amdgcn_exp2f(st.m - mn);
        st.m = mn; st.l *= alpha; st.o0 = st.o0 * alpha; st.o1 = st.o1 * alpha;
    }
    const float msub = on ? st.m : INFINITY;
    f32x2 acc2 = {0.f, 0.f};
#pragma unroll
    for (int i = 0; i < 8; ++i) {
        f32x2 v = {s[2 * i], s[2 * i + 1]}; v = v - msub;
        v.x = __builtin_amdgcn_exp2f(v.x); v.y = __builtin_amdgcn_exp2f(v.y);
        s[2 * i] = v.x; s[2 * i + 1] = v.y; acc2 = acc2 + v;
    }
    st.l += acc2.x + acc2.y;
#pragma unroll
    for (int si = 0; si < 2; ++si) {
        const bf16x8 pb = pack8(s, si);
        st.o0 = MFMA32(vf[si * 2], pb, st.o0);
        st.o1 = MFMA32(vf[si * 2 + 1], pb, st.o1);
    }
}
DI void load_k(bf16x8 (&kf)[4], const bf16_t* kb, const Tile& t) {
#pragma unroll
    for (int q = 0; q < 4; ++q) kf[q] = GLD8(kb + t.ko + 512 * q);
}
DI void load_v(bf16x8 (&vf)[4], const bf16_t* vb, const Tile& t) {
#pragma unroll
    for (int q = 0; q < 4; ++q) vf[q] = GLD8(vb + t.vo + 512 * q);
}
template <class ST, class Next, class Mask>
DI void attend(ST& st, const bf16x8 (&qf)[4], const bf16_t* kb, const bf16_t* vb, Next& next, Mask& mask, int h) {
    Tile ta, tb;
    if (!next(ta)) return;
    bf16x8 kA[4], kB[4], vf[4];
    load_k(kA, kb, ta);
    for (;;) {
        const bool hb = next(tb);
        load_v(vf, vb, ta);
        if (hb) load_k(kB, kb, tb);
        attend_tile(st, qf, kA, vf, mask, ta.aux, h);
        if (!hb) break;
        const bool ha = next(ta);
        load_v(vf, vb, tb);
        if (ha) load_k(kA, kb, ta);
        attend_tile(st, qf, kB, vf, mask, tb.aux, h);
        if (!ha) break;
    }
}
template <class ST> DI float fs_inv(ST& st) { const float l = st.l + __shfl_xor(st.l, 32); return l > 0.f ? 1.0f / l : 0.f; }
DI void store_o(bf16_t* orow, const f32x16& a0, const f32x16& a1, int h) {
#pragma unroll
    for (int g = 0; g < 4; ++g) {
        u32x2 w0; w0.x = pk2(a0[4 * g], a0[4 * g + 1]); w0.y = pk2(a0[4 * g + 2], a0[4 * g + 3]);
        u32x2 w1; w1.x = pk2(a1[4 * g], a1[4 * g + 1]); w1.y = pk2(a1[4 * g + 2], a1[4 * g + 3]);
        *(__attribute__((address_space(1))) u32x2*)(orow + 8 * g + 4 * h) = w0; *(__attribute__((address_space(1))) u32x2*)(orow + 32 + 8 * g + 4 * h) = w1;
    }
}

template <bool FAST>
DI void mem_item(const Params& p, int layer, int it, int lane) {
    unsigned char* ws = p.ws;
    const int r = lane & 31, h = lane >> 5;
    const int tile = it & 127, mh = (it >> 7) & 3, b = it >> 9;
    const size_t tok = (size_t)b * S + tile * 32 + r;
    const bf16_t* qrow = layer == 0 ? (const bf16_t*)(ws + WS_PROJ0) + tok * PROJ_LD + 1920 + mh * 64 : (const bf16_t*)(ws + WS_QKV1) + tok * QKV1_LD + 2560 + mh * 64;
    bf16x8 qf[4]; load_q_norm<false>(qf, qrow, p.mem_q_norm + layer * 64, nullptr, h);
    const bf16_t* kb = (const bf16_t*)(ws + WS_MEMKF) + (size_t)((layer * 8 + b) * 4 + mh) * NMEM * 64 + lane * 8;
    const bf16_t* vb = (const bf16_t*)(ws + WS_MEMVF) + (size_t)((layer * 8 + b) * 4 + mh) * NMEM * 64 + lane * 8;
    int ti = 0;
    auto next = [&](Tile& t) -> bool { if (ti >= 8) return false; t.ko = ti * 2048; t.vo = ti * 2048; t.aux = 0; ++ti; return true; };
    struct { DI bool full(int) const { return true; } DI bool lane(int) const { return true; } DI int prep(int) const { return 0; } DI bool elem(int, int) const { return true; } } mask;
    FSx<FAST> st; fs_init(st);
    attend(st, qf, kb, vb, next, mask, h);
    const float inv = fs_inv(st);
    bf16_t* orow = layer == 0 ? (bf16_t*)(ws + WS_ATT0) + tok * 1024 + 768 + mh * 64 : (bf16_t*)(ws + WS_ATT1) + tok * 768 + 512 + mh * 64;
    store_o(orow, st.o0 * inv, st.o1 * inv, h);
}

template <class ST> DI void softmax_p(ST& st, f32x16& s, bf16x8 (&pk)[2], bool on) {
    if constexpr (ST::fast) {
        f32x2 acc2 = {0.f, 0.f};
#pragma unroll
        for (int i = 0; i < 8; ++i) { f32x2 v; v.x = __builtin_amdgcn_exp2f(s[2 * i]); v.y = __builtin_amdgcn_exp2f(s[2 * i + 1]); s[2 * i] = v.x; s[2 * i + 1] = v.y; acc2 = acc2 + v; }
        st.l += on ? (acc2.x + acc2.y) : 0.f;
        const unsigned onm = on ? 0xffffffffu : 0u;
#pragma unroll
        for (int si = 0; si < 2; ++si) { u32x4 w = __builtin_bit_cast(u32x4, pack8(s, si)); w = w & onm; pk[si] = __builtin_bit_cast(bf16x8, w); }
        return;
    }
    float mx = rowmax16(s);
    mx = on ? mx : -INFINITY;
    if (__any(mx > st.m + 6.0f)) {
        mx = fmaxf(mx, __shfl_xor(mx, 32));
        const float mn = fmaxf(st.m, mx);
        const float alpha = __builtin_amdgcn_exp2f(st.m - mn);
        st.m = mn; st.l *= alpha; st.o0 = st.o0 * alpha; st.o1 = st.o1 * alpha;
    }
    const float msub = on ? st.m : INFINITY;
    f32x2 acc2 = {0.f, 0.f};
#pragma unroll
    for (int i = 0; i < 8; ++i) {
        f32x2 v = {s[2 * i], s[2 * i + 1]}; v = v - msub;
        v.x = __builtin_amdgcn_exp2f(v.x); v.y = __builtin_amdgcn_exp2f(v.y);
        s[2 * i] = v.x; s[2 * i + 1] = v.y; acc2 = acc2 + v;
    }
    st.l += acc2.x + acc2.y;
#pragma unroll
    for (int si = 0; si < 2; ++si) pk[si] = pack8(s, si);
}
template <class ST> DI void pv_acc(ST& st, const bf16x8 (&pk)[2], const bf16x8 (&vf)[4]) {
#pragma unroll
    for (int si = 0; si < 2; ++si) { st.o0 = MFMA32(vf[si * 2], pk[si], st.o0); st.o1 = MFMA32(vf[si * 2 + 1], pk[si], st.o1); }
}
template <class ST, class Next, class Mask>
DI void attend2(ST& s0, ST& s1, const bf16x8 (&q0)[4], const bf16x8 (&q1)[4], const bf16_t* kb, const bf16_t* vb, Next& next, Mask& mask) {
    Tile cur;
    if (!next(cur)) return;
    bf16x8 kf[4], vf[4];
    load_k(kf, kb, cur);
    for (;;) {
        Tile nx; const bool hn = next(nx);
        load_v(vf, vb, cur);
        f32x16 sa = zero16(), sb = zero16();
#pragma unroll
        for (int ks = 0; ks < 4; ++ks) { sa = MFMA32(kf[ks], q0[ks], sa); sb = MFMA32(kf[ks], q1[ks], sb); }
        if (hn) load_k(kf, kb, nx);
        if (!mask.full(cur.aux)) {
            const int d = mask.prep(cur.aux);
#pragma unroll
            for (int i = 0; i < 16; ++i) { const bool ok = mask.elem(d, (i & 3) + 8 * (i >> 2)); sa[i] = ok ? sa[i] : -INFINITY; sb[i] = ok ? sb[i] : -INFINITY; }
        }
        const bool on = mask.lane(cur.aux);
        bf16x8 pa[2], pb[2];
        softmax_p(s0, sa, pa, on);
        softmax_p(s1, sb, pb, on);
        pv_acc(s0, pa, vf);
        pv_acc(s1, pb, vf);
        if (!hn) break;
        cur = nx;
    }
}
DI void rmw_o(bf16_t* orow, const f32x16& a0, const f32x16& a1, int h, bool first) {
#pragma unroll
    for (int g = 0; g < 4; ++g) {
        __attribute__((address_space(1))) u32x2* p0 = (__attribute__((address_space(1))) u32x2*)(orow + 8 * g + 4 * h);
        __attribute__((address_space(1))) u32x2* p1 = (__attribute__((address_space(1))) u32x2*)(orow + 32 + 8 * g + 4 * h);
        float b0[4] = {0.f, 0.f, 0.f, 0.f}, b1[4] = {0.f, 0.f, 0.f, 0.f};
        if (!first) { const u32x2 x0 = *p0, x1 = *p1; b0[0] = bflo(x0.x); b0[1] = bfhi(x0.x); b0[2] = bflo(x0.y); b0[3] = bfhi(x0.y); b1[0] = bflo(x1.x); b1[1] = bfhi(x1.x); b1[2] = bflo(x1.y); b1[3] = bfhi(x1.y); }
        u32x2 w0; w0.x = pk2(a0[4 * g] + b0[0], a0[4 * g + 1] + b0[1]); w0.y = pk2(a0[4 * g + 2] + b0[2], a0[4 * g + 3] + b0[3]);
        u32x2 w1; w1.x = pk2(a1[4 * g] + b1[0], a1[4 * g + 1] + b1[1]); w1.y = pk2(a1[4 * g + 2] + b1[2], a1[4 * g + 3] + b1[3]);
        *p0 = w0; *p1 = w1;
    }
}

template <bool FAST>
DI void nsa_item2(const Params& p, unsigned char* smem, int c64, int bg, bool valid, int w4, int slot, int lane) {
    unsigned char* ws = p.ws;
    const int b = bg / 3, g = bg % 3;
    const int r = lane & 31, h = lane >> 5, qh = w4 >> 1, hp = w4 & 1, head0 = g * 4 + hp * 2;
    const int t0 = c64 * 64 + qh * 32, t = t0 + r;
    const size_t tok = (size_t)b * S + t;
    const bf16_t* proj = (const bf16_t*)(ws + WS_PROJ0);
    float* imp = (float*)(smem + slot * 33792);
    u64* selmask = (u64*)(smem + 2 * 33792 + slot * 512);
    bf16x8 q0[4], q1[4];
    { const float* rr = (const float*)(ws + WS_ROPE) + (size_t)t * 64;
      load_q_norm<true>(q0, proj + tok * PROJ_LD + head0 * 64, p.a_q_norm, rr, h); load_q_norm<true>(q1, proj + tok * PROJ_LD + head0 * 64 + 64, p.a_q_norm, rr, h); }
    const float* gp = (const float*)(ws + WS_GATES) + tok * 36 + head0 * 3;
    const float gc0 = gp[0], gs0 = gp[1], gw0 = gp[2], gc1 = gp[3], gs1 = gp[4], gw1 = gp[5];
    bf16_t* orow = (bf16_t*)(ws + WS_ATT0) + tok * 1024 + head0 * 64;
    if (valid) {
        const bf16_t* kcb = (const bf16_t*)(ws + WS_KCF) + (size_t)bg * 256 * 64 + lane * 8;
        const bf16_t* vcb = (const bf16_t*)(ws + WS_VCF) + (size_t)bg * 256 * 64 + lane * 8;
        int ncv = t0 / 16 + 1; if (ncv > NCMP) ncv = NCMP;
        const int nct = (ncv + 31) >> 5;
        float m0 = -1e30f, l0 = 0.f, m1 = -1e30f, l1 = 0.f;
        bf16x8 kc[4], kn[4];
#pragma unroll
        for (int ks = 0; ks < 4; ++ks) kc[ks] = GLD8(kcb + 512 * ks);
#pragma unroll 1
        for (int ct = 0; ct < nct; ++ct) {
            const int cn = ct + 1 < nct ? ct + 1 : 0;
#pragma unroll
            for (int ks = 0; ks < 4; ++ks) kn[ks] = GLD8(kcb + cn * 2048 + 512 * ks);
            f32x16 sa = zero16(), sb = zero16();
#pragma unroll
            for (int ks = 0; ks < 4; ++ks) { sa = MFMA32(kc[ks], q0[ks], sa); sb = MFMA32(kc[ks], q1[ks], sb); }
#pragma unroll
            for (int ks = 0; ks < 4; ++ks) kc[ks] = kn[ks];
            float mxa = -INFINITY, mxb = -INFINITY;
#pragma unroll
            for (int i = 0; i < 16; ++i) { const int c = ct * 32 + crow(i, h); const bool ok = (c * 16 + 31 <= t); sa[i] = ok ? sa[i] : -INFINITY; sb[i] = ok ? sb[i] : -INFINITY; mxa = fmaxf(mxa, sa[i]); mxb = fmaxf(mxb, sb[i]); }
            mxa = fmaxf(mxa, __shfl_xor(mxa, 32)); mxb = fmaxf(mxb, __shfl_xor(mxb, 32));
            const float mna = fmaxf(m0, mxa), mnb = fmaxf(m1, mxb);
            float lsa = 0.f, lsb = 0.f;
#pragma unroll
            for (int i = 0; i < 16; ++i) { lsa += __builtin_amdgcn_exp2f(sa[i] - mna); lsb += __builtin_amdgcn_exp2f(sb[i] - mnb); }
            l0 = l0 * __builtin_amdgcn_exp2f(m0 - mna) + lsa; m0 = mna;
            l1 = l1 * __builtin_amdgcn_exp2f(m1 - mnb) + lsb; m1 = mnb;
        }
        l0 += __shfl_xor(l0, 32); l1 += __shfl_xor(l1, 32);
        const float il0 = l0 > 0.f ? 1.0f / l0 : 0.f, il1 = l1 > 0.f ? 1.0f / l1 : 0.f;
        f32x16 oa0 = zero16(), oa1 = zero16(), ob0 = zero16(), ob1 = zero16();
        float carry = 0.f;
        float* impw = imp + ((hp * 2 + qh) * 32 + r) * 65;
#pragma unroll 1
        for (int ct = 0; ct < 8; ++ct) {
            if (ct < nct) {
                bf16x8 vc[4];
#pragma unroll
                for (int q = 0; q < 4; ++q) vc[q] = GLD8(vcb + ct * 2048 + 512 * q);
                const int cn = ct + 1 < nct ? ct + 1 : ct;
#pragma unroll
                for (int ks = 0; ks < 4; ++ks) kn[ks] = GLD8(kcb + cn * 2048 + 512 * ks);
                f32x16 sa = zero16(), sb = zero16();
#pragma unroll
                for (int ks = 0; ks < 4; ++ks) { sa = MFMA32(kc[ks], q0[ks], sa); sb = MFMA32(kc[ks], q1[ks], sb); }
#pragma unroll
                for (int ks = 0; ks < 4; ++ks) kc[ks] = kn[ks];
#pragma unroll
                for (int i = 0; i < 16; ++i) { const int c = ct * 32 + crow(i, h); const bool ok = (c * 16 + 31 <= t);
                    sa[i] = ok ? __builtin_amdgcn_exp2f(sa[i] - m0) : 0.f; sb[i] = ok ? __builtin_amdgcn_exp2f(sb[i] - m1) : 0.f; }
#pragma unroll
                for (int si = 0; si < 2; ++si) {
                    const bf16x8 pa = pack8(sa, si), pb = pack8(sb, si);
                    oa0 = MFMA32(vc[2 * si], pa, oa0); oa1 = MFMA32(vc[2 * si + 1], pa, oa1);
                    ob0 = MFMA32(vc[2 * si], pb, ob0); ob1 = MFMA32(vc[2 * si + 1], pb, ob1);
                }
#pragma unroll
                for (int i = 0; i < 16; ++i) sa[i] = sa[i] * il0 + sb[i] * il1;
                float y3[4];
#pragma unroll
                for (int q = 0; q < 4; ++q) y3[q] = __shfl_xor(sa[4 * q + 3], 32);
#pragma unroll
                for (int q = 0; q < 4; ++q) {
                    const float quad = (sa[4 * q] + sa[4 * q + 1]) + (sa[4 * q + 2] + sa[4 * q + 3]);
                    const float prev = h ? y3[q] : (q ? y3[q > 0 ? q - 1 : 0] : carry);
                    impw[ct * 8 + 2 * q + h] = quad + prev;
                }
                carry = y3[3];
            } else {
#pragma unroll
                for (int q = 0; q < 4; ++q) impw[ct * 8 + 2 * q + h] = 0.f;
            }
        }
        const float f0 = gc0 * il0, f1 = gc1 * il1;
        rmw_o(orow, oa0 * f0, oa1 * f0, h, true);
        rmw_o(orow + 64, ob0 * f1, ob1 * f1, h, true);
    }
    __syncthreads();
    if (valid) {
        const int cur = c64, j = lane;
#pragma unroll 1
        for (int n0 = 0; n0 < 16; n0 += 4) {
            float v[4]; unsigned key[4], thr[4];
#pragma unroll
            for (int u = 0; u < 4; ++u) {
                const int tq = w4 * 16 + n0 + u, qh2 = tq >> 5, r2 = tq & 31;
                float x = imp[((0 * 2 + qh2) * 32 + r2) * 65 + j] + imp[((1 * 2 + qh2) * 32 + r2) * 65 + j];
                const bool forced = (j == 0) || (j == cur) || (j == cur - 1);
                x = forced ? 1e9f : (j <= cur ? x : -1e30f);
                v[u] = x;
                const unsigned vb = __builtin_bit_cast(unsigned, x); key[u] = (vb & 0x80000000u) ? ~vb : (vb | 0x80000000u); thr[u] = 0u;
            }
#pragma unroll
            for (int bit = 31; bit >= 0; --bit) {
#pragma unroll
                for (int u = 0; u < 4; ++u) { const unsigned cand = thr[u] | (1u << bit); if (__builtin_popcountll(__ballot(key[u] >= cand)) >= 16) thr[u] = cand; }
            }
#pragma unroll
            for (int u = 0; u < 4; ++u) {
                const u64 gt = __ballot(key[u] > thr[u]), eq = __ballot(key[u] == thr[u]);
                const int need = 16 - __builtin_popcountll(gt);
                const int eqrank = __builtin_popcountll(eq & ((1ull << j) - 1ull));
                const bool sel = ((key[u] > thr[u]) || (key[u] == thr[u] && eqrank < need)) && (v[u] > -5e29f);
                const u64 mk = __ballot(sel);
                if (lane == 0) selmask[w4 * 16 + n0 + u] = mk;
            }
        }
    }
    __syncthreads();
    if (valid) {
        {
            const u64 mym = selmask[qh * 32 + r];
            unsigned ulo = (unsigned)mym, uhi = (unsigned)(mym >> 32);
#pragma unroll
            for (int o = 1; o < 32; o <<= 1) { ulo |= __shfl_xor(ulo, o); uhi |= __shfl_xor(uhi, o); }
            u64 un = ((u64)(unsigned)__builtin_amdgcn_readfirstlane(uhi) << 32) | (unsigned)__builtin_amdgcn_readfirstlane(ulo);
            int sub = 0;
            const bf16_t* kb = (const bf16_t*)(ws + WS_KSELF) + (size_t)bg * S * 64 + lane * 8;
            const bf16_t* vb = (const bf16_t*)(ws + WS_VSELF) + (size_t)bg * S * 64 + lane * 8;
            auto next = [&](Tile& tl) -> bool {
                if (!un) return false;
                const int jb = __builtin_ctzll(un); const int pb = jb * 64 + sub * 32;
                tl.ko = pb * 64; tl.vo = pb * 64; tl.aux = pb;
                if (sub == 1 || pb + 32 > t0 + 31) { un &= un - 1; sub = 0; } else sub = 1;
                return true; };
            struct M { u64 mym; int th, t0; DI bool full(int pb) const { return pb + 31 <= t0; } DI bool lane(int pb) const { return (mym >> (pb >> 6)) & 1ull; } DI int prep(int pb) const { return th - pb; } DI bool elem(int d, int ci) const { return ci <= d; } } mask{mym, t - 4 * h, t0};
            FSx<FAST> s0, s1; fs_init(s0); fs_init(s1);
            attend2(s0, s1, q0, q1, kb, vb, next, mask);
            const float f0 = gs0 * fs_inv(s0), f1 = gs1 * fs_inv(s1);
            rmw_o(orow, s0.o0 * f0, s0.o1 * f0, h, false);
            rmw_o(orow + 64, s1.o0 * f1, s1.o1 * f1, h, false);
        }
        {
            int wt = (t0 >= 512 ? t0 - 512 : 0) >> 5; const int wend = t0 >> 5;
            const bf16_t* kb = (const bf16_t*)(ws + WS_KWINF) + (size_t)bg * S * 64 + lane * 8;
            const bf16_t* vb = (const bf16_t*)(ws + WS_VWINF) + (size_t)bg * S * 64 + lane * 8;
            auto next = [&](Tile& tl) -> bool { if (wt > wend) return false; const int pb = wt * 32; tl.ko = pb * 64; tl.vo = pb * 64; tl.aux = pb; ++wt; return true; };
            struct M { int th, t0; DI bool full(int pb) const { return pb + 31 <= t0 && pb >= t0 - 480; } DI bool lane(int) const { return true; } DI int prep(int pb) const { return th - pb; } DI bool elem(int d, int ci) const { return (unsigned)(d - ci) < 512u; } } mask{t - 4 * h, t0};
            FSx<FAST> s0, s1; fs_init(s0); fs_init(s1);
            attend2(s0, s1, q0, q1, kb, vb, next, mask);
            const float f0 = gw0 * fs_inv(s0), f1 = gw1 * fs_inv(s1);
            rmw_o(orow, s0.o0 * f0, s0.o1 * f0, h, false);
            rmw_o(orow + 64, s1.o0 * f1, s1.o1 * f1, h, false);
        }
    }
    __syncthreads();
}
template <bool FAST>
DI void phase_attn0_t(const Params& p, unsigned char* smem, int bid, int G, int wave, int lane) {
    const int slot = wave >> 2, w4 = wave & 3;
    if (wave >= 4) __builtin_amdgcn_s_setprio(1);
    if (G == 256) {
        const int xcd = bid & 7, l = bid >> 3;
        for (int rd = 0; rd < 3; ++rd) {
            int k = l;
            if (rd == 1) k = l < 16 ? 31 - 2 * l : 2 * (31 - l);
            else if (rd == 2) k = l == 0 ? 31 : (l < 16 ? l + 15 : l - 16);
            nsa_item2<FAST>(p, smem, 63 - (2 * k + slot), xcd + 8 * rd, true, w4, slot, lane);
        }
    } else {
        for (int rd = 0; rd * 2 * G < 1536; ++rd) {
            const int pr = rd * G + ((rd & 1) ? (G - 1 - bid) : bid), it = 2 * pr + slot;
            const bool valid = it < 1536; const int itc = valid ? it : 0;
            nsa_item2<FAST>(p, smem, 63 - itc / 24, itc % 24, valid, w4, slot, lane);
        }
    }
    const int gw = bid * 8 + wave, NGW = G * 8;
    for (int it = gw; it < 4096; it += NGW) mem_item<FAST>(p, 0, it, lane);
    __builtin_amdgcn_s_setprio(0);
}
DI void phase_attn0(const Params& p, unsigned char* smem, int bid, int G, int wave, int lane) {
    const bool fast = __builtin_amdgcn_readfirstlane(*(const int*)(p.ws + WS_FLAG)) != 0;
    if (fast) phase_attn0_t<true>(p, smem, bid, G, wave, lane); else phase_attn0_t<false>(p, smem, bid, G, wave, lane);
}

template <int GI, class ST>
DI void dil_group(const Params& p, ST& st, int b, int hs, int sp, int r16, int lane) {
    unsigned char* ws = p.ws;
    constexpr int dil = GI == 0 ? 1 : (GI == 1 ? 4 : 16), clen = S / dil;
    const int r = lane & 31, h = lane >> 5;
    const int t = sp * 512 + r16 + 16 * r, rc = r16 % dil, qc = t / dil;
    const bf16_t* qkv = (const bf16_t*)(ws + WS_QKV1);
    bf16x8 qf[4]; load_q_norm<true>(qf, qkv + ((size_t)b * S + t) * QKV1_LD + 1024 + GI * 512 + hs * 64, p.b_q_norm + GI * 64, (const float*)(ws + WS_ROPE) + (size_t)t * 64, h);
    const int cbase = sp * 512 / dil;
    int ti = (cbase >= 128 ? cbase - 128 : 0) >> 5; const int tend = (cbase + 512 / dil - 1) >> 5;
    const size_t cb = (size_t)(b * 8 + hs) * S * 64 + (size_t)rc * clen * 64 + lane * 8;
    const bf16_t* kb = (const bf16_t*)(ws + (GI == 0 ? WS_KF1 : (GI == 1 ? WS_KF4 : WS_KF16))) + cb;
    const bf16_t* vb = (const bf16_t*)(ws + (GI == 0 ? WS_VF1 : (GI == 1 ? WS_VF4 : WS_VF16))) + cb;
    auto next = [&](Tile& tl) -> bool { if (ti > tend) return false; const int k0 = ti * 32; tl.ko = k0 * 64; tl.vo = k0 * 64; tl.aux = k0; ++ti; return true; };
    struct M { int qh, lo, hi; DI bool full(int k0) const { return k0 >= lo && k0 <= hi; } DI bool lane(int) const { return true; } DI int prep(int k0) const { return qh - k0; } DI bool elem(int d, int ci) const { return (unsigned)(d - ci) <= 128u; } } mask{qc - 4 * h, GI == 2 ? sp * 32 - 97 : 1, GI == 2 ? sp * 32 - 31 : 0};
    attend(st, qf, kb, vb, next, mask, h);
}
template <int GI, bool FAST>
DI void dil_pass_a(const Params& p, bf16_t* os, float* lses, int b, int hs, int sp, int qt, int lane) {
    unsigned char* ws = p.ws;
    constexpr int dil = GI == 0 ? 1 : 4, clen = S / dil, nq = 16 / dil;
    const int r = lane & 31, h = lane >> 5;
    const int rc = qt / nq, qi = qt % nq;
    const int c0 = sp * (512 / dil) + qi * 32, qc = c0 + r;
    const int tl = rc + dil * (qi * 32 + r), t = sp * 512 + tl;
    const bf16_t* qkv = (const bf16_t*)(ws + WS_QKV1);
    bf16x8 qf[4]; load_q_norm<true>(qf, qkv + ((size_t)b * S + t) * QKV1_LD + 1024 + GI * 512 + hs * 64, p.b_q_norm + GI * 64, (const float*)(ws + WS_ROPE) + (size_t)t * 64, h);
    const size_t cb = (size_t)(b * 8 + hs) * S * 64 + (size_t)rc * clen * 64 + lane * 8;
    const bf16_t* kb = (const bf16_t*)(ws + (GI == 0 ? WS_KF1 : WS_KF4)) + cb; const bf16_t* vb = (const bf16_t*)(ws + (GI == 0 ? WS_VF1 : WS_VF4)) + cb;
    int k0 = c0 >= 128 ? c0 - 128 : 0;
    auto next = [&](Tile& tile) -> bool { if (k0 > c0) return false; tile.ko = k0 * 64; tile.vo = k0 * 64; tile.aux = k0; k0 += 32; return true; };
    struct M { int th, c0; DI bool full(int kk) const { return kk + 31 <= c0 && kk >= c0 - 96; } DI bool lane(int) const { return true; } DI int prep(int kk) const { return th - kk; } DI bool elem(int d, int ci) const { return (unsigned)(d - ci) <= 128u; } } mask{qc - 4 * h, c0};
    FSx<FAST> st; fs_init(st);
    attend(st, qf, kb, vb, next, mask, h);
    const float l = st.l + __shfl_xor(st.l, 32);
    const float inv = 1.0f / l;
    if (h == 0) lses[tl] = st.m + __builtin_amdgcn_logf(l);
    bf16_t* orow = os + tl * 68;
#pragma unroll
    for (int g = 0; g < 4; ++g) {
        u32x2 w0; w0.x = pk2(st.o0[4 * g] * inv, st.o0[4 * g + 1] * inv); w0.y = pk2(st.o0[4 * g + 2] * inv, st.o0[4 * g + 3] * inv);
        u32x2 w1; w1.x = pk2(st.o1[4 * g] * inv, st.o1[4 * g + 1] * inv); w1.y = pk2(st.o1[4 * g + 2] * inv, st.o1[4 * g + 3] * inv);
        *(u32x2*)(orow + 8 * g + 4 * h) = w0; *(u32x2*)(orow + 32 + 8 * g + 4 * h) = w1;
    }
}
template <bool FAST>
DI void dil_span_item(const Params& p, unsigned char* smem, int it, int wave, int lane) {
    unsigned char* ws = p.ws;
    const int sp = it & 7, hs = (it >> 3) & 7, b = it >> 6;
    const int r = lane & 31, h = lane >> 5;
    bf16_t* o0s = (bf16_t*)smem;
    bf16_t* o1s = (bf16_t*)(smem + 512 * 136);
    float* lse0 = (float*)(smem + 2 * 512 * 136);
    float* lse1 = lse0 + 512;
#pragma unroll 1
    for (int u = 0; u < 2; ++u) dil_pass_a<0, FAST>(p, o0s, lse0, b, hs, sp, wave * 2 + u, lane);
#pragma unroll 1
    for (int u = 0; u < 2; ++u) dil_pass_a<1, FAST>(p, o1s, lse1, b, hs, sp, wave * 2 + u, lane);
    __syncthreads();
#pragma unroll 1
    for (int u = 0; u < 2; ++u) {
        const int r16 = wave * 2 + u, tl = r16 + 16 * r, t = sp * 512 + tl;
        FSx<FAST> st; fs_init(st);
        dil_group<2>(p, st, b, hs, sp, r16, lane);
        const float l2 = st.l + __shfl_xor(st.l, 32);
        const float x2 = st.m + __builtin_amdgcn_logf(l2), x0 = lse0[tl], x1 = lse1[tl];
        const float mm = fmaxf(fmaxf(x0, x1), x2), e0 = __builtin_amdgcn_exp2f(x0 - mm), e1 = __builtin_amdgcn_exp2f(x1 - mm), e2 = __builtin_amdgcn_exp2f(x2 - mm), rden = 1.0f / (e0 + e1 + e2);
        const float a0 = e0 * rden, a1 = e1 * rden, a2 = e2 * rden / l2;
        const bf16_t* ra = o0s + tl * 68; const bf16_t* rb = o1s + tl * 68;
        f32x16 r0, r1;
#pragma unroll
        for (int g = 0; g < 4; ++g) {
            const u32x2 x0a = *(const u32x2*)(ra + 8 * g + 4 * h), x1a = *(const u32x2*)(ra + 32 + 8 * g + 4 * h);
            const u32x2 x0b = *(const u32x2*)(rb + 8 * g + 4 * h), x1b = *(const u32x2*)(rb + 32 + 8 * g + 4 * h);
            r0[4 * g] = st.o0[4 * g] * a2 + bflo(x0a.x) * a0 + bflo(x0b.x) * a1; r0[4 * g + 1] = st.o0[4 * g + 1] * a2 + bfhi(x0a.x) * a0 + bfhi(x0b.x) * a1;
            r0[4 * g + 2] = st.o0[4 * g + 2] * a2 + bflo(x0a.y) * a0 + bflo(x0b.y) * a1; r0[4 * g + 3] = st.o0[4 * g + 3] * a2 + bfhi(x0a.y) * a0 + bfhi(x0b.y) * a1;
            r1[4 * g] = st.o1[4 * g] * a2 + bflo(x1a.x) * a0 + bflo(x1b.x) * a1; r1[4 * g + 1] = st.o1[4 * g + 1] * a2 + bfhi(x1a.x) * a0 + bfhi(x1b.x) * a1;
            r1[4 * g + 2] = st.o1[4 * g + 2] * a2 + bflo(x1a.y) * a0 + bflo(x1b.y) * a1; r1[4 * g + 3] = st.o1[4 * g + 3] * a2 + bfhi(x1a.y) * a0 + bfhi(x1b.y) * a1;
        }
        store_o((bf16_t*)(ws + WS_ATT1) + ((size_t)b * S + t) * 768 + hs * 64, r0, r1, h);
    }
    __syncthreads();
}
template <bool FAST>
DI void phase_attn1_t(const Params& p, unsigned char* smem, int bid, int G, int wave, int lane) {
    const int gw = bid * 8 + wave, NGW = G * 8;
    if (wave >= 4) __builtin_amdgcn_s_setprio(1);
    if (G == 256) {
        const int xcd = bid & 7, l = bid >> 3;
        for (int rd = 0; rd < 2; ++rd) { const int bh = rd * 32 + xcd * 4 + (l >> 3); dil_span_item<FAST>(p, smem, bh * 8 + (l & 7), wave, lane); }
    } else {
        for (int it = bid; it < 512; it += G) dil_span_item<FAST>(p, smem, it, wave, lane);
    }
    for (int it = gw; it < 4096; it += NGW) mem_item<FAST>(p, 1, it, lane);
    __builtin_amdgcn_s_setprio(0);
}
DI void phase_attn1(const Params& p, unsigned char* smem, int bid, int G, int wave, int lane) {
    const bool fast = __builtin_amdgcn_readfirstlane(*(const int*)(p.ws + WS_FLAG)) != 0;
    if (fast) phase_attn1_t<true>(p, smem, bid, G, wave, lane); else phase_attn1_t<false>(p, smem, bid, G, wave, lane);
}
__global__ void __launch_bounds__(512, 2) yoco_fwd(Params pk) {
    extern __shared__ __attribute__((aligned(16))) unsigned char smem[];
    cg::grid_group grid = cg::this_grid();
    const int tid = threadIdx.x, lane = tid & 63, wave = __builtin_amdgcn_readfirstlane(tid >> 6);
    const int bid = blockIdx.x, G = gridDim.x, gw = bid * 8 + wave, NGW = G * 8;
    unsigned char* const ws = pk.ws;
    PG8_LAS unsigned char* lds = (PG8_LAS unsigned char*)smem;
    bf16_t* const Hb = (bf16_t*)(ws + WS_H);
    volatile LAS unsigned* misc = (volatile LAS unsigned*)((LAS unsigned char*)smem + LDS_MISC);
    if (tid < 2) misc[tid] = 0u;
    __syncthreads();
    const XcdBarrier xbar = xcd_barrier_post((unsigned*)(ws + WS_BAR), misc);
#define GSYNC() xcd_barrier(xbar)
#define GEMM_STORE(ACT, Aptr, Bptr, M_, N_, K_, Optr, LDC, BIAS) do { pg8::Gemm g{(const bf16_t*)(Aptr), (const bf16_t*)(Bptr), (M_), (N_), (K_)}; \
        pg8::EpiStore<ACT> E; E.O = (bf16_t*)(Optr); E.ldc = (LDC); E.bias = nullptr; E.rowss = (BIAS); pg8::StaticOrder So; So.init((M_), (N_), G, bid); \
        pg8::gemm_phase<pg8::EpiStore<ACT>, pg8::StaticOrder, true, true>(lds, g, So, E); } while (0)
#define GEMM_RES(Aptr, Bptr, K_, BASEF, BASEH, OUTF, HB, HB2, RSS) do { LDP(); pg8::Gemm g{(const bf16_t*)(Aptr), (const bf16_t*)(Bptr), T, DM, (K_)}; \
        pg8::EpiRes E; E.basef = (BASEF); E.baseh = (BASEH); E.outf = (OUTF); E.ldc = DM; E.hb = (HB); E.hb2 = (HB2); E.rowss = (RSS); pg8::StaticOrder So; So.init(T, DM, G, bid); \
        pg8::gemm_phase<pg8::EpiRes, pg8::StaticOrder, true, true>(lds, g, So, E); } while (0)
    float* const RS0 = (float*)(ws + WS_RSS);
#define NOF ((float*)nullptr)
#define NOH ((bf16_t*)nullptr)
    { if (bid == 0 && tid < (int)(sizeof(Params) / 8)) ((u64*)(ws + WS_PARAMS))[tid] = ((const u64*)&pk)[tid];
      phase_prep(pk, smem, gw, NGW, wave, lane); }
    if (pk.ws == nullptr) grid.sync();
    GSYNC();
#define LDP() const Params p = *(const Params*)(ws + WS_PARAMS)
    GEMM_STORE(0, Hb, ws + WS_WAIN, T, PROJ_LD, DM, ws + WS_PROJ0, PROJ_LD, nullptr);
    GSYNC();
    { LDP(); phase_post0(p, smem, gw, NGW, wave, lane); }
    GSYNC();
    if (G >= 80) {
        if (bid < 48) {
            const int i = bid / 24;
            pg8::Gemm g{(const bf16_t*)(ws + WS_TB) + (size_t)i * CMP_ROWS_PAD * 2048, (const bf16_t*)(ws + WS_WC1) + (size_t)i * 2048 * 256, CMP_ROWS_PAD, 256, 2048};
            pg8::EpiStore<1> E; E.O = (bf16_t*)(ws + WS_HID) + (size_t)i * CMP_ROWS_PAD * 256; E.ldc = 256; E.bias = (const float*)(ws + WS_B1P) + i * 256; E.rowss = nullptr;
            pg8::StaticOrder So; So.init(CMP_ROWS_PAD, 256, 24, bid - 24 * i);
            pg8::gemm_phase<pg8::EpiStore<1>, pg8::StaticOrder, true, true>(lds, g, So, E);
        } else if (bid < 80) {
            pg8::Gemm g{(const bf16_t*)(ws + WS_MEMN), (const bf16_t*)(ws + WS_WMKV), NB * NMEM, 1024, DM};
            pg8::EpiStore<0> E; E.O = (bf16_t*)(ws + WS_MEMKV); E.ldc = 1024; E.bias = nullptr; E.rowss = nullptr;
            pg8::StaticOrder So; So.init(NB * NMEM, 1024, 32, bid - 48);
            pg8::gemm_phase<pg8::EpiStore<0>, pg8::StaticOrder, true, true>(lds, g, So, E);
        } else { LDP(); prep_weights_b(p, smem, (bid - 80) * 8 + wave, (G - 80) * 8, wave, lane); }
    } else {
        { LDP(); prep_weights_b(p, smem, gw, NGW, wave, lane); }
        for (int i = 0; i < 2; ++i) {
            pg8::Gemm g{(const bf16_t*)(ws + WS_TB) + (size_t)i * CMP_ROWS_PAD * 2048, (const bf16_t*)(ws + WS_WC1) + (size_t)i * 2048 * 256, CMP_ROWS_PAD, 256, 2048};
            pg8::EpiStore<1> E; E.O = (bf16_t*)(ws + WS_HID) + (size_t)i * CMP_ROWS_PAD * 256; E.ldc = 256; E.bias = (const float*)(ws + WS_B1P) + i * 256; E.rowss = nullptr;
            pg8::StaticOrder So; So.init(CMP_ROWS_PAD, 256, G, bid);
            pg8::gemm_phase<pg8::EpiStore<1>, pg8::StaticOrder, true, true>(lds, g, So, E);
        }
        GEMM_STORE(0, ws + WS_MEMN, ws + WS_WMKV, NB * NMEM, 1024, DM, ws + WS_MEMKV, 1024, nullptr);
    }
    GSYNC();
    { LDP(); phase_cmp2(p, gw, NGW, lane); phase_mempost(p, smem, gw, NGW, wave, lane); }
    GSYNC();
    { LDP(); phase_attn0(p, smem, bid, G, wave, lane); }
    GSYNC();
    GEMM_RES(ws + WS_ATT0, ws + WS_WAOUT, 1024, p.x, NOH, NOF, Hb, NOH, RS0);
    GSYNC();
    GEMM_STORE(2, Hb, ws + WS_WUP, T, FF, DM, ws + WS_U, FF, RS0);
    GSYNC();
    GEMM_RES(ws + WS_U, ws + WS_WDN, FF, NOF, Hb, NOF, Hb, (bf16_t*)p.out, RS0 + T);
    GSYNC();
    GEMM_STORE(0, Hb, ws + WS_WKVB, T, QKV1_LD, DM, ws + WS_QKV1, QKV1_LD, RS0 + T);
    GSYNC();
    { LDP(); phase_post1(p, smem, gw, NGW, wave, lane); }
    GSYNC();
    { LDP(); phase_attn1(p, smem, bid, G, wave, lane); }
    GSYNC();
    GEMM_RES(ws + WS_ATT1, ws + WS_WBOUT, 768, NOF, (const bf16_t*)p.out, NOF, Hb, NOH, RS0 + 2 * T);
    GSYNC();
    GEMM_STORE(2, Hb, (const bf16_t*)(ws + WS_WUP) + (size_t)DM * FF, T, FF, DM, ws + WS_U, FF, RS0 + 2 * T);
    GSYNC();
    GEMM_RES(ws + WS_U, (const bf16_t*)(ws + WS_WDN) + (size_t)DM * FF, FF, NOF, Hb, p.out, NOH, NOH, NOF);
}

extern "C" void kernel_launch(void* const* d_in, const int* in_sizes, int n_in, void* d_out, int out_size, void* d_ws, size_t ws_size, hipStream_t stream) {
    static int grid = 0;
    if (grid == 0) {
        if (n_in != 25 || out_size != T * DM || ws_size < WS_END) { fprintf(stderr, "kernel_launch: unexpected problem (n_in %d, out %d, ws %zu)\n", n_in, out_size, ws_size); grid = -1; return; }
        int dev = 0, cus = 0, per_cu = 0;
        hipGetDevice(&dev); hipDeviceGetAttribute(&cus, hipDeviceAttributeMultiprocessorCount, dev);
        if (hipFuncSetAttribute((const void*)yoco_fwd, hipFuncAttributeMaxDynamicSharedMemorySize, LDS_BYTES) != hipSuccess) { fprintf(stderr, "kernel_launch: hipFuncSetAttribute failed\n"); grid = -1; return; }
        if (hipOccupancyMaxActiveBlocksPerMultiprocessor(&per_cu, (const void*)yoco_fwd, 512, LDS_BYTES) != hipSuccess || per_cu < 1) { fprintf(stderr, "kernel_launch: occupancy query says %d blocks/CU\n", per_cu); (void)hipGetLastError(); per_cu = 1; }
        grid = cus * 1;
        if (grid <= 0) grid = 256;
    }
    if (grid < 0) return;
    if (hipMemsetAsync((char*)d_ws + WS_BAR, 0, BAR_BYTES, stream) != hipSuccess) { fprintf(stderr, "kernel_launch: memset failed\n"); return; }
    Params p{};
    const float** pp = (const float**)&p;
    for (int i = 0; i < 25; ++i) pp[i] = (const float*)d_in[i];
    p.out = (float*)d_out; p.ws = (unsigned char*)d_ws;
    void* args[] = {&p};
    hipError_t e = hipLaunchCooperativeKernel((const void*)yoco_fwd, dim3(grid), dim3(512), args, LDS_BYTES, stream);
    if (e != hipSuccess) fprintf(stderr, "cooperative launch failed: %s (grid %d)\n", hipGetErrorString(e), grid);
}
```

```cpp
#include <hip/hip_runtime.h>
#include <hip/hip_cooperative_groups.h>
#include <cstdio>
#include <cstdint>
namespace cg = cooperative_groups;
namespace pg8 {
#define PG8_LAS __attribute__((address_space(3)))
typedef unsigned short bf16_t;
typedef short bf16x8 __attribute__((ext_vector_type(8)));
typedef float f32x4 __attribute__((ext_vector_type(4)));
typedef unsigned u32x4 __attribute__((ext_vector_type(4)));
constexpr int BM = 256, BK = 64, HALF = 128, HTB = HALF * BK * 2  , STAGE_BYTES = 8 * HTB, NXCD = 8, WGM = 8;

__host__ __device__ __forceinline__ int lds_byte(int r, int c) { const int st = (r >> 4) * 2 + (c >> 5), rr = r & 15, cc = c & 31, ob = rr * 64 + cc * 2; return st * 1024 + (ob ^ (((ob >> 9) & 1) << 5)); }
__host__ __device__ __forceinline__ void stage_rc(int b, int& R, int& C) { const int st = b / 1024, sb = b % 1024, swz = sb ^ (((sb >> 9) & 1) << 5); R = (st >> 1) * 16 + swz / 64; C = (st & 1) * 32 + (swz % 64) / 2; }
__host__ __device__ __forceinline__ int perm32(int rho) { const int n = rho >> 4, i = rho & 15; return 8 * (i >> 2) + 4 * n + (i & 3); }

struct Unit { int pm, pn; };
struct Gemm { const bf16_t* A; const bf16_t* Bt; int M, N, K; };

struct StaticOrder {
    int nM, nN, nwg, G, c;
    __host__ __device__ void init(int M, int N, int G_, int c_) { nM = M / BM; nN = N / BM; nwg = nM * nN; G = G_; c = c_; }
    __host__ __device__ bool next(int i, Unit& u) const {
        const long L = (long)i * G + c; if (L >= nwg) return false;
        int wgid = (int)L; { const int q = nwg / NXCD, r = nwg % NXCD, xcd = wgid % NXCD, off = wgid / NXCD; wgid = (xcd < r ? xcd * (q + 1) : r * (q + 1) + (xcd - r) * q) + off; }
        const int nig = WGM * nN, gid = wgid / nig, fm = gid * WGM, gsz = (nM - fm) < WGM ? (nM - fm) : WGM;
        u.pm = fm + ((wgid % nig) % gsz); u.pn = (wgid % nig) / gsz; return true;
    }
    __device__ __forceinline__ void a_ready(const Unit&) const {}
    __device__ __forceinline__ void done(const Unit&) const {}
};

__device__ __forceinline__ unsigned cvt_pk_bf16(float lo, float hi) { unsigned r; asm volatile("v_cvt_pk_bf16_f32 %0, %1, %2" : "=v"(r) : "v"(lo), "v"(hi)); return r; }
__device__ __forceinline__ float gelu_tanh(float x) {
    const float u = 0.7978845608028654f * (x + 0.044715f * x * x * x);
    const float e = __builtin_amdgcn_exp2f(u * 2.885390081777927f);
    const float th = 1.0f - 2.0f * __builtin_amdgcn_rcpf(1.0f + e);
    return 0.5f * x * (1.0f + th);
}
template <int ACT> struct EpiStore {
    static constexpr bool PERM = true, AFTER_DRAIN = false;
    bf16_t* O; int ldc; const float* bias; const float* rowss;
    __device__ __forceinline__ void operator()(const f32x4 (&acc)[2][2][4][2], const Unit& u, int wr, int wc, int fr, int fq) const {
        const int row0 = u.pm * BM + wr * 64 + fr; const int col0 = u.pn * BM + wc * 32 + 8 * fq;
        f32x4 bv[2][2];
#pragma unroll
        for (int bj = 0; bj < 2; ++bj)
#pragma unroll
            for (int n = 0; n < 2; ++n) bv[bj][n] = (ACT == 1) ? *(const f32x4*)(bias + col0 + bj * HALF + 4 * n) : (f32x4){0.f, 0.f, 0.f, 0.f};
#pragma unroll
        for (int ai = 0; ai < 2; ++ai)
#pragma unroll
            for (int m = 0; m < 4; ++m) { bf16_t* rowp = O + (size_t)(row0 + ai * HALF + m * 16) * ldc + col0;
                float rs = 1.0f; if (rowss) rs = 1.0f / sqrtf(rowss[row0 + ai * HALF + m * 16] * (1.0f / 1024.0f) + 1e-6f);
                if (ACT == 2) rs = rs * rs;
#pragma unroll
                for (int bj = 0; bj < 2; ++bj) { f32x4 v0 = acc[ai][bj][m][0], v1 = acc[ai][bj][m][1];
                    if (ACT == 1) { v0 = v0 + bv[bj][0]; v1 = v1 + bv[bj][1];
#pragma unroll
                        for (int e = 0; e < 4; ++e) { v0[e] = gelu_tanh(v0[e]); v1[e] = gelu_tanh(v1[e]); } }
                    if (ACT == 2) {
#pragma unroll
                        for (int e = 0; e < 4; ++e) { float a = fmaxf(v0[e], 0.f), b = fmaxf(v1[e], 0.f); v0[e] = a * a; v1[e] = b * b; } }
                    v0 = v0 * rs; v1 = v1 * rs;
                    u32x4 w; w.x = cvt_pk_bf16(v0[0], v0[1]); w.y = cvt_pk_bf16(v0[2], v0[3]); w.z = cvt_pk_bf16(v1[0], v1[1]); w.w = cvt_pk_bf16(v1[2], v1[3]);
                    *(u32x4*)(rowp + bj * HALF) = w; } }
    }
};
struct EpiRes {
    static constexpr bool PERM = true, AFTER_DRAIN = false;
    const float* basef; const bf16_t* baseh; float* outf; int ldc; bf16_t* hb; bf16_t* hb2; float* rowss;
    __device__ __forceinline__ void operator()(const f32x4 (&acc)[2][2][4][2], const Unit& u, int wr, int wc, int fr, int fq) const {
        const int row0 = u.pm * BM + wr * 64 + fr; const int col0 = u.pn * BM + wc * 32 + 8 * fq;
        float ss[8];
#pragma unroll
        for (int ai = 0; ai < 2; ++ai)
#pragma unroll
            for (int m = 0; m < 4; ++m) { const size_t off = (size_t)(row0 + ai * HALF + m * 16) * ldc + col0;
                float ssq = 0.f;
#pragma unroll
                for (int bj = 0; bj < 2; ++bj) {
                    f32x4 b0, b1;
                    if (basef) { b0 = *(const f32x4*)(basef + off + bj * HALF); b1 = *(const f32x4*)(basef + off + bj * HALF + 4); }
                    else { const u32x4 r = *(const u32x4*)(baseh + off + bj * HALF);
                        b0 = (f32x4){__builtin_bit_cast(float, r.x << 16), __builtin_bit_cast(float, r.x & 0xffff0000u), __builtin_bit_cast(float, r.y << 16), __builtin_bit_cast(float, r.y & 0xffff0000u)};
                        b1 = (f32x4){__builtin_bit_cast(float, r.z << 16), __builtin_bit_cast(float, r.z & 0xffff0000u), __builtin_bit_cast(float, r.w << 16), __builtin_bit_cast(float, r.w & 0xffff0000u)}; }
                    const f32x4 n0 = b0 + acc[ai][bj][m][0], n1 = b1 + acc[ai][bj][m][1];
                    if (outf) { *(f32x4*)(outf + off + bj * HALF) = n0; *(f32x4*)(outf + off + bj * HALF + 4) = n1; }
                    if (hb) { ssq += (n0[0] * n0[0] + n0[1] * n0[1]) + (n0[2] * n0[2] + n0[3] * n0[3]) + (n1[0] * n1[0] + n1[1] * n1[1]) + (n1[2] * n1[2] + n1[3] * n1[3]);
                        u32x4 w; w.x = cvt_pk_bf16(n0[0], n0[1]); w.y = cvt_pk_bf16(n0[2], n0[3]); w.z = cvt_pk_bf16(n1[0], n1[1]); w.w = cvt_pk_bf16(n1[2], n1[3]);
                        *(u32x4*)(hb + off + bj * HALF) = w; if (hb2) *(u32x4*)(hb2 + off + bj * HALF) = w; } }
                if (hb) { ssq += __shfl_xor(ssq, 16); ssq += __shfl_xor(ssq, 32); }
                ss[ai * 4 + m] = ssq; }
        if (hb) {
            const float va = fq == 0 ? ss[0] : (fq == 1 ? ss[1] : (fq == 2 ? ss[2] : ss[3]));
            const float vb = fq == 0 ? ss[4] : (fq == 1 ? ss[5] : (fq == 2 ? ss[6] : ss[7]));
            (void)__hip_atomic_fetch_add(rowss + row0 + fq * 16, va, __ATOMIC_RELAXED, __HIP_MEMORY_SCOPE_AGENT);
            (void)__hip_atomic_fetch_add(rowss + row0 + HALF + fq * 16, vb, __ATOMIC_RELAXED, __HIP_MEMORY_SCOPE_AGENT);
        }
    }
};
template <class Epi, class Sched, bool ALIGN_EPI = false, bool SP2 = false>
__device__ __forceinline__ void gemm_phase(PG8_LAS unsigned char* lds, const Gemm g, const Sched& S, const Epi& E) {
    int tid_ = threadIdx.x; asm volatile("" : "+v"(tid_));
    const int tid = tid_, wid = __builtin_amdgcn_readfirstlane(tid >> 6), lane = tid & 63, wr = wid >> 2, wc = wid & 3, fr = lane & 15, fq = lane >> 4;
    const int K = g.K, nt = K / BK;
    unsigned voffA[2], voffB[2];
#pragma unroll
    for (int i = 0; i < 2; ++i) { int R, C; stage_rc(tid * 16 + i * 8192, R, C); const int Rb = Epi::PERM ? ((R & ~31) + perm32(R & 31)) : R;
        voffA[i] = (unsigned)(R * K + C) * 2u; voffB[i] = (unsigned)(Rb * K + C) * 2u; }
    const size_t kstep = (size_t)(BK * 2);
    const size_t hstep = (size_t)HALF * K * 2;
    const size_t tstep = 2 * hstep;
    const unsigned ldsw = (unsigned)wid * 1024u;
    const int aoff = lds_byte(wr * 64 + fr, fq * 8), boff = lds_byte(wc * 32 + fr, fq * 8);
#define PG8_SA(b, h) (((b) * 2 + (h)) * HTB)
#define PG8_SB(b, h) ((4 + (b) * 2 + (h)) * HTB)
#define PG8_STAGE(bufoff, gbase, voff) do { _Pragma("unroll") for (int _i = 0; _i < 2; ++_i) \
        __builtin_amdgcn_global_load_lds((const unsigned*)((const char*)(gbase) + (voff)[_i]), (PG8_LAS unsigned*)(lds + (bufoff) + ldsw + _i * 8192), 16, 0, 0); } while (0)
#define PG8_LDA(dst, b, h) do { _Pragma("unroll") for (int m = 0; m < 4; ++m) _Pragma("unroll") for (int k = 0; k < 2; ++k) dst[m][k] = *(const PG8_LAS bf16x8*)(lds + PG8_SA(b, h) + aoff + m * 2048 + k * 1024); } while (0)
#define PG8_LDB(dst, b, h) do { _Pragma("unroll") for (int n = 0; n < 2; ++n) _Pragma("unroll") for (int k = 0; k < 2; ++k) dst[n][k] = *(const PG8_LAS bf16x8*)(lds + PG8_SB(b, h) + boff + n * 2048 + k * 1024); } while (0)
#define PG8_MMA(ai, bj, At, Bt) do { __builtin_amdgcn_s_setprio(1); _Pragma("unroll") for (int m = 0; m < 4; ++m) _Pragma("unroll") for (int n = 0; n < 2; ++n) _Pragma("unroll") for (int k = 0; k < 2; ++k) \
        acc[ai][bj][m][n] = __builtin_amdgcn_mfma_f32_16x16x32_bf16(Bt[n][k], At[m][k], acc[ai][bj][m][n], 0, 0, 0); __builtin_amdgcn_s_setprio(0); } while (0)
#define PG8_WAIT_V(n) asm volatile("s_waitcnt vmcnt(" #n ")" ::: "memory")
#define PG8_WAIT_L(n) asm volatile("s_waitcnt lgkmcnt(" #n ")" ::: "memory")
#define PG8_BAR __builtin_amdgcn_s_barrier()
#define PG8_SCHED __builtin_amdgcn_sched_barrier(0)
    Unit cur, nxt; int ui = 0;
    if (!S.next(0, cur)) return;
    f32x4 acc[2][2][4][2];
#pragma unroll
    for (int a = 0; a < 2; ++a)
#pragma unroll
        for (int b = 0; b < 2; ++b)
#pragma unroll
            for (int m = 0; m < 4; ++m)
#pragma unroll
                for (int n = 0; n < 2; ++n) acc[a][b][m][n] = (f32x4){0.f, 0.f, 0.f, 0.f};
    bf16x8 At[4][2], B0[2][2], B1[2][2];
    const char* cA = (const char*)g.A + (size_t)cur.pm * tstep; const char* cB = (const char*)g.Bt + (size_t)cur.pn * tstep;
    S.a_ready(cur);
    if constexpr (SP2) {
        PG8_STAGE(PG8_SB(0, 0), cB, voffB); PG8_STAGE(PG8_SB(0, 1), cB + hstep, voffB); PG8_STAGE(PG8_SA(0, 0), cA, voffA); PG8_STAGE(PG8_SA(0, 1), cA + hstep, voffA);
        if (wr == 1) PG8_BAR;
        PG8_WAIT_V(2); PG8_BAR;
        PG8_STAGE(PG8_SB(1, 0), cB + kstep, voffB); PG8_STAGE(PG8_SA(1, 0), cA + kstep, voffA); PG8_STAGE(PG8_SB(1, 1), cB + hstep + kstep, voffB);
        PG8_WAIT_V(6); PG8_BAR;
    } else {
        PG8_STAGE(PG8_SB(0, 0), cB, voffB); PG8_STAGE(PG8_SA(0, 0), cA, voffA); PG8_STAGE(PG8_SB(0, 1), cB + hstep, voffB); PG8_STAGE(PG8_SA(0, 1), cA + hstep, voffA);
        if (wr == 1) PG8_BAR;
        PG8_WAIT_V(4); PG8_BAR;
        PG8_STAGE(PG8_SB(1, 0), cB + kstep, voffB); PG8_STAGE(PG8_SA(1, 0), cA + kstep, voffA); PG8_STAGE(PG8_SB(1, 1), cB + hstep + kstep, voffB);
        PG8_WAIT_V(6); PG8_BAR;
    }
    for (;;) {
        const bool has_next = S.next(ui + 1, nxt);
        const char* nA = has_next ? (const char*)g.A + (size_t)nxt.pm * tstep : cA; const char* nB = has_next ? (const char*)g.Bt + (size_t)nxt.pn * tstep : cB;
        for (int t = 0; t < nt; t += 2) {
            const bool last = (t == nt - 2);
            const char* a1 = cA + (size_t)(t + 1) * kstep;
            const char* a2 = last ? nA : cA + (size_t)(t + 2) * kstep; const char* b2 = last ? nB : cB + (size_t)(t + 2) * kstep;
            const char* a3 = a2 + kstep; const char* b3 = b2 + kstep;
            if (last && has_next) S.a_ready(nxt);
            if constexpr (SP2) {
            PG8_LDB(B0, 0, 0); PG8_LDB(B1, 0, 1); PG8_SCHED; PG8_LDA(At, 0, 0); PG8_STAGE(PG8_SA(1, 1), a1 + hstep, voffA);
            PG8_WAIT_V(8); PG8_WAIT_L(0); PG8_BAR; PG8_MMA(0, 0, At, B0); PG8_MMA(0, 1, At, B1); PG8_BAR; PG8_SCHED;
            PG8_LDA(At, 0, 1); PG8_STAGE(PG8_SB(0, 0), b2, voffB); PG8_STAGE(PG8_SB(0, 1), b2 + hstep, voffB); PG8_STAGE(PG8_SA(0, 0), a2, voffA);
            PG8_WAIT_V(8); PG8_WAIT_L(0); PG8_BAR; PG8_MMA(1, 0, At, B0); PG8_MMA(1, 1, At, B1); PG8_BAR; PG8_SCHED;
            PG8_LDB(B0, 1, 0); PG8_LDB(B1, 1, 1); PG8_SCHED; PG8_LDA(At, 1, 0); PG8_STAGE(PG8_SA(0, 1), a2 + hstep, voffA);
            PG8_WAIT_V(8); PG8_WAIT_L(0); PG8_BAR; PG8_MMA(0, 0, At, B0); PG8_MMA(0, 1, At, B1); PG8_BAR; PG8_SCHED;
            PG8_LDA(At, 1, 1); PG8_STAGE(PG8_SB(1, 0), b3, voffB); PG8_STAGE(PG8_SB(1, 1), b3 + hstep, voffB); PG8_STAGE(PG8_SA(1, 0), a3, voffA);
            PG8_WAIT_V(8); PG8_WAIT_L(0); PG8_BAR; PG8_MMA(1, 0, At, B0); PG8_MMA(1, 1, At, B1); PG8_BAR; PG8_SCHED;
            } else {
            PG8_LDB(B0, 0, 0); PG8_SCHED; PG8_LDA(At, 0, 0); PG8_STAGE(PG8_SA(1, 1), a1 + hstep, voffA);
            PG8_WAIT_L(8); PG8_BAR; PG8_WAIT_L(0); PG8_MMA(0, 0, At, B0); PG8_BAR; PG8_SCHED;
            PG8_LDB(B1, 0, 1); PG8_STAGE(PG8_SB(0, 0), b2, voffB);
            PG8_BAR; PG8_WAIT_L(0); PG8_MMA(0, 1, At, B1); PG8_BAR;
            PG8_LDA(At, 0, 1); PG8_STAGE(PG8_SA(0, 0), a2, voffA);
            PG8_BAR; PG8_WAIT_L(0); PG8_MMA(1, 0, At, B0); PG8_BAR; PG8_SCHED;
            PG8_STAGE(PG8_SB(0, 1), b2 + hstep, voffB);
            PG8_WAIT_V(6); PG8_BAR; PG8_MMA(1, 1, At, B1); PG8_BAR;
            PG8_LDB(B0, 1, 0); PG8_SCHED; PG8_LDA(At, 1, 0); PG8_STAGE(PG8_SA(0, 1), a2 + hstep, voffA);
            PG8_WAIT_L(8); PG8_BAR; PG8_WAIT_L(0); PG8_MMA(0, 0, At, B0); PG8_BAR; PG8_SCHED;
            PG8_LDB(B1, 1, 1); PG8_STAGE(PG8_SB(1, 0), b3, voffB);
            PG8_BAR; PG8_WAIT_L(0); PG8_MMA(0, 1, At, B1); PG8_BAR;
            PG8_LDA(At, 1, 1); PG8_STAGE(PG8_SA(1, 0), a3, voffA);
            PG8_BAR; PG8_WAIT_L(0); PG8_MMA(1, 0, At, B0); PG8_BAR; PG8_SCHED;
            PG8_STAGE(PG8_SB(1, 1), b3 + hstep, voffB);
            PG8_WAIT_V(6); PG8_BAR; PG8_MMA(1, 1, At, B1); PG8_BAR;
            }
        }
        if constexpr (ALIGN_EPI) { if (wr == 0) PG8_BAR; }
        if constexpr (!Epi::AFTER_DRAIN) { E(acc, cur, wr, wc, fr, fq); S.done(cur); }
        if (!has_next) break;
#pragma unroll
        for (int a = 0; a < 2; ++a)
#pragma unroll
            for (int b = 0; b < 2; ++b)
#pragma unroll
                for (int m = 0; m < 4; ++m)
#pragma unroll
                    for (int n = 0; n < 2; ++n) acc[a][b][m][n] = (f32x4){0.f, 0.f, 0.f, 0.f};
        cur = nxt; cA = nA; cB = nB; ++ui;
        if constexpr (ALIGN_EPI) { if (wr == 1) PG8_BAR; }
    }
    PG8_WAIT_V(0);
    if constexpr (!ALIGN_EPI) { if (wr == 0) PG8_BAR; }
    PG8_BAR;
    if constexpr (Epi::AFTER_DRAIN) { E.fused(acc, cur, wr, wc, fr, fq, lds, wid, lane); S.done(cur); }
#undef PG8_SA
#undef PG8_SB
#undef PG8_STAGE
#undef PG8_LDA
#undef PG8_LDB
#undef PG8_MMA
#undef PG8_WAIT_V
#undef PG8_WAIT_L
#undef PG8_BAR
#undef PG8_SCHED
}
}
typedef unsigned short bf16_t;
typedef short bf16x8 __attribute__((ext_vector_type(8)));
typedef short s16x4 __attribute__((ext_vector_type(4)));
typedef float f32x4 __attribute__((ext_vector_type(4)));
typedef float f32x16 __attribute__((ext_vector_type(16)));
typedef unsigned u32x4 __attribute__((ext_vector_type(4)));
typedef unsigned u32x2 __attribute__((ext_vector_type(2)));
typedef unsigned long long u64;
#define DI __device__ __forceinline__
#define MFMA32(a, b, c) __builtin_amdgcn_mfma_f32_32x32x16_bf16((a), (b), (c), 0, 0, 0)
#define LDS_WAIT() asm volatile("s_waitcnt lgkmcnt(0)" ::: "memory")

constexpr int NB = 8, S = 4096, DM = 1024, T = NB * S, FF = 4096, NMEM = 256;
constexpr int PROJ_LD = 2304, QKV1_LD = 2816, NCMP = 255, CMP_ROWS = 6120, CMP_ROWS_PAD = 6144;
constexpr float EPS = 1e-6f;
constexpr float SC2 = 0.125f * 1.4426950408889634f;
constexpr size_t MiB = 1u << 20;
constexpr size_t WS_WAIN = 0, WS_WAOUT = 5 * MiB, WS_WUP = 7 * MiB, WS_WDN = 23 * MiB, WS_WMKV = 39 * MiB, WS_WKVB = 41 * MiB, WS_WBOUT = 47 * MiB, WS_WC1 = 49 * MiB;
constexpr size_t WS_PARAMS = 51 * MiB + 32768, WS_FLAG = 51 * MiB + 32768 + 1024, WS_B1P = 51 * MiB, WS_B1PART = 51 * MiB + 65536, WS_ROPE = 52 * MiB, WS_MEMN = 53 * MiB, WS_MEMKV = 57 * MiB, WS_MEMVF = 61 * MiB, WS_HID = 63 * MiB;
constexpr size_t WS_KCF = 69 * MiB, WS_VCF = 70 * MiB, WS_GATES = 71 * MiB, WS_MEMKF = 76 * MiB;
constexpr size_t WS_H = 80 * MiB, WS_VF1 = 80 * MiB, WS_VF4 = 112 * MiB;
constexpr size_t WS_TB = 144 * MiB, WS_VF16 = 144 * MiB, WS_KF1 = 176 * MiB;
constexpr size_t WS_R1 = 208 * MiB, WS_PROJ0 = WS_R1, WS_ATT0 = WS_R1 + 144 * MiB, WS_VSELF = WS_R1 + 208 * MiB, WS_VWINF = WS_R1 + 220 * MiB, WS_KSELF = WS_R1 + 232 * MiB, WS_KWINF = WS_R1 + 244 * MiB;
constexpr size_t WS_U = WS_R1, WS_QKV1 = WS_R1, WS_ATT1 = WS_R1 + 176 * MiB, WS_KF4 = 432 * MiB, WS_KF16 = 464 * MiB, WS_END = 496 * MiB;
constexpr int LDS_BYTES = 147456, LDS_MISC = 147392;
constexpr size_t WS_BAR = 51 * MiB + 131072, BAR_BYTES = 16384, WS_RSS = 51 * MiB + 262144;

struct Params {
    const float *x, *mem, *attn_norm, *mlp_norm, *w_up, *w_down, *mem_norm, *w_mem_kv, *mem_q_norm, *mem_k_norm,
        *a_w_in, *a_w_out, *a_q_norm, *a_k_norm, *a_cmp_pos, *a_cmp_w1, *a_cmp_b1, *a_cmp_w2, *a_cmp_b2,
        *kv_norm, *w_kv_shared, *kv_k_norm, *b_w_in, *b_w_out, *b_q_norm;
    float* out; unsigned char* ws;
};

DI unsigned f2bf(float f) { unsigned u = __builtin_bit_cast(unsigned, f); return (u + 0x7fffu + ((u >> 16) & 1u)) >> 16; }
DI unsigned pk2(float lo, float hi) { return f2bf(lo) | (f2bf(hi) << 16); }
DI float bflo(unsigned u) { return __builtin_bit_cast(float, u << 16); }
DI float bfhi(unsigned u) { return __builtin_bit_cast(float, u & 0xffff0000u); }
DI float bf2f(bf16_t b) { return __builtin_bit_cast(float, (unsigned)b << 16); }
DI float wave_sum(float v) {
#pragma unroll
    for (int o = 1; o < 64; o <<= 1) v += __shfl_xor(v, o);
    return v;
}
DI int crow(int reg, int h) { return (reg & 3) + 8 * (reg >> 2) + 4 * h; }
DI f32x16 zero16() { f32x16 z; for (int i = 0; i < 16; ++i) z[i] = 0.f; return z; }
DI bf16x8 pack8(const f32x16& x, int s) {
    u32x4 p;
#pragma unroll
    for (int j = 0; j < 4; ++j) p[j] = pg8::cvt_pk_bf16(x[8 * s + 2 * j], x[8 * s + 2 * j + 1]);
    return __builtin_bit_cast(bf16x8, p);
}

DI void wt_item(const float* W, int K, int N, int nblk, const float* gain, bf16_t* WT, int row_off, float* scr, int item, int lane) {
    const int kb = item / nblk, nb = item % nblk, k0 = 64 * kb, n0 = 32 * nb;
    const int n4 = n0 + (lane & 7) * 4;
    f32x4 v[8];
#pragma unroll
    for (int i = 0; i < 8; ++i) { const int kk = i * 8 + (lane >> 3);
        v[i] = (n4 < N) ? *(const __attribute__((address_space(1))) f32x4*)(W + (size_t)(k0 + kk) * N + n4) : (f32x4){0.f, 0.f, 0.f, 0.f}; }
#pragma unroll
    for (int i = 0; i < 8; ++i) { const int kk = i * 8 + (lane >> 3); f32x4 t = v[i]; if (gain) t = t * gain[k0 + kk];
        float* d = scr + kk * 33 + (lane & 7) * 4; d[0] = t.x; d[1] = t.y; d[2] = t.z; d[3] = t.w; }
    LDS_WAIT();
    const int c = lane & 7;
#pragma unroll
    for (int j = 0; j < 4; ++j) { const int n = (lane >> 3) + 8 * j; const float* s = scr + (8 * c) * 33 + n;
        u32x4 o; o.x = pk2(s[0 * 33], s[1 * 33]); o.y = pk2(s[2 * 33], s[3 * 33]); o.z = pk2(s[4 * 33], s[5 * 33]); o.w = pk2(s[6 * 33], s[7 * 33]);
        *(__attribute__((address_space(1))) u32x4*)(WT + (size_t)(row_off + n0 + n) * K + k0 + 8 * c) = o; }
    LDS_WAIT();
}
DI void rms_row_to_bf16(const float* xrow, bf16_t* orow, int lane) {
    const f32x4* xr = (const f32x4*)xrow + lane;
    f32x4 v[4]; float s = 0.f;
#pragma unroll
    for (int j = 0; j < 4; ++j) { v[j] = xr[64 * j]; s += (v[j].x * v[j].x + v[j].y * v[j].y) + (v[j].z * v[j].z + v[j].w * v[j].w); }
    const float rstd = 1.0f / sqrtf(wave_sum(s) * (1.f / DM) + EPS);
    u64* o8 = (u64*)orow + lane;
#pragma unroll
    for (int j = 0; j < 4; ++j) o8[64 * j] = (u64)pk2(v[j].x * rstd, v[j].y * rstd) | ((u64)pk2(v[j].z * rstd, v[j].w * rstd) << 32);
}
DI void norm_rows(const float* src, bf16_t* dst, int nrows, int gw, int NGW, int lane) {
    for (int m = gw; m < nrows; m += NGW) rms_row_to_bf16(src + (size_t)m * DM, dst + (size_t)m * DM, lane);
}

DI void prep_weights_a(const Params& p, unsigned char* smem, int gw, int NGW, int wave, int lane) {
    unsigned char* ws = p.ws;
    float* scr = (float*)(smem + wave * 8704);
    constexpr int I_AIN = 16 * 72, I_MKV = 16 * 16, I_C1 = 32 * 8;
    constexpr int NITEMS = I_AIN + 2 * I_MKV + 2 * I_C1;
    for (int it = gw; it < NITEMS; it += NGW) {
        int r = it;
        if (r < I_AIN) { wt_item(p.a_w_in, 1024, 2212, 72, p.attn_norm, (bf16_t*)(ws + WS_WAIN), 0, scr, r, lane); continue; } r -= I_AIN;
        if (r < 2 * I_MKV) { const int l = r / I_MKV; wt_item(p.w_mem_kv + (size_t)l * DM * 512, 1024, 512, 16, p.mem_norm + l * DM, (bf16_t*)(ws + WS_WMKV), l * 512, scr, r % I_MKV, lane); continue; } r -= 2 * I_MKV;
        { const int i = r / I_C1; wt_item(p.a_cmp_w1 + (size_t)i * 2048 * 256, 2048, 256, 8, nullptr, (bf16_t*)(ws + WS_WC1) + (size_t)i * 2048 * 256, 0, scr, r % I_C1, lane); }
    }
}
DI void prep_weights_b(const Params& p, unsigned char* smem, int gw, int NGW, int wave, int lane) {
    unsigned char* ws = p.ws;
    float* scr = (float*)(smem + wave * 8704);
    constexpr int I_AOUT = 16 * 32, I_UP = 16 * 128, I_DN = 64 * 32, I_KVS = 16 * 32, I_BIN = 16 * 56, I_BOUT = 12 * 32;
    constexpr int NITEMS = I_AOUT + 2 * I_UP + 2 * I_DN + I_KVS + I_BIN + I_BOUT;
    for (int it = gw; it < NITEMS; it += NGW) {
        int r = it;
        if (r < I_AOUT) { wt_item(p.a_w_out, 1024, 1024, 32, nullptr, (bf16_t*)(ws + WS_WAOUT), 0, scr, r, lane); continue; } r -= I_AOUT;
        if (r < 2 * I_UP) { const int l = r / I_UP; wt_item(p.w_up + (size_t)l * DM * FF, 1024, 4096, 128, p.mlp_norm + l * DM, (bf16_t*)(ws + WS_WUP) + (size_t)l * DM * FF, 0, scr, r % I_UP, lane); continue; } r -= 2 * I_UP;
        if (r < 2 * I_DN) { const int l = r / I_DN; wt_item(p.w_down + (size_t)l * DM * FF, 4096, 1024, 32, nullptr, (bf16_t*)(ws + WS_WDN) + (size_t)l * DM * FF, 0, scr, r % I_DN, lane); continue; } r -= 2 * I_DN;
        if (r < I_KVS) { wt_item(p.w_kv_shared, 1024, 1024, 32, p.kv_norm, (bf16_t*)(ws + WS_WKVB), 0, scr, r, lane); continue; } r -= I_KVS;
        if (r < I_BIN) { wt_item(p.b_w_in, 1024, 1792, 56, p.attn_norm + DM, (bf16_t*)(ws + WS_WKVB), 1024, scr, r, lane); continue; } r -= I_BIN;
        wt_item(p.b_w_out, 768, 1024, 32, nullptr, (bf16_t*)(ws + WS_WBOUT), 0, scr, r, lane);
    }
}
DI void phase_prep(const Params& p, unsigned char* smem, int gw, int NGW, int wave, int lane) {
    unsigned char* ws = p.ws;
    prep_weights_a(p, smem, gw, NGW, wave, lane);
    norm_rows(p.x, (bf16_t*)(ws + WS_H), T, gw, NGW, lane);
    norm_rows(p.mem, (bf16_t*)(ws + WS_MEMN), NB * NMEM, gw, NGW, lane);
    const int gtid = gw * 64 + lane, NT = NGW * 64;
    for (int idx = gtid; idx < 3 * T; idx += NT) ((float*)(ws + WS_RSS))[idx] = 0.f;
    float* rope = (float*)(ws + WS_ROPE);
    for (int idx = gtid; idx < S * 32; idx += NT) {
        const int pos = idx >> 5, fi = idx & 31;
        const float inv = powf(10000.0f, -(float)fi / 32.0f);
        const float ang = (float)pos * inv;
        const double ad = (double)ang; const double k = rint(ad * 0.15915494309189535); const float rr = (float)(ad - k * 6.283185307179586);
        rope[2 * idx] = cosf(rr); rope[2 * idx + 1] = sinf(rr);
    }
    if (gtid == 0) {
        auto mx = [](const float* w) { float m = 0.f; for (int i = 0; i < 64; ++i) m = fmaxf(m, fabsf(w[i])); return m; };
        const float aq = mx(p.a_q_norm), kvk = mx(p.kv_k_norm);
        float worst = fmaxf(aq * mx(p.a_k_norm + 64), aq * mx(p.a_k_norm + 128));
        worst = fmaxf(worst, fmaxf(mx(p.mem_q_norm) * mx(p.mem_k_norm), mx(p.mem_q_norm + 64) * mx(p.mem_k_norm + 64)));
        worst = fmaxf(worst, kvk * fmaxf(mx(p.b_q_norm), fmaxf(mx(p.b_q_norm + 64), mx(p.b_q_norm + 128))));
        *(int*)(ws + WS_FLAG) = (64.0f * SC2 * 1.03f * worst <= 60.0f) ? 1 : 0;
    }
    float* part = (float*)(ws + WS_B1PART);
    for (int idx = gtid; idx < 16 * 512; idx += NT) {
        const int kc = idx >> 9, in = idx & 511, i = in >> 8, n = in & 255;
        const float* w1 = p.a_cmp_w1 + (size_t)i * 2048 * 256 + (size_t)(kc * 128) * 256 + n; const float* ps = p.a_cmp_pos + i * 2048 + kc * 128;
        float a = 0.f;
        for (int k = 0; k < 128; ++k) a += ps[k] * w1[(size_t)k * 256];
        part[idx] = a;
    }
}
#define LAS __attribute__((address_space(3)))
#define XB_TMO      128
#define XB_XCNT(j)  (256  + 64 * (j))
#define XB_XSUB(j)  (1280 + 64 * (j))
#define XB_XGEN(j)  (2304 + 64 * (j))
#define XB_TOP      3328
#define XB_TOPGEN   3392
#define XCD_BAR_WORDS 3456
#define XB_SPIN_CAP (1u << 18)

__device__ __forceinline__ unsigned xb_ld(unsigned* p)              { return __hip_atomic_load(p, __ATOMIC_RELAXED, __HIP_MEMORY_SCOPE_AGENT); }
__device__ __forceinline__ unsigned xb_add(unsigned* p, unsigned v) { return __hip_atomic_fetch_add(p, v, __ATOMIC_RELAXED, __HIP_MEMORY_SCOPE_AGENT); }
__device__ __forceinline__ unsigned xb_xcc_id() { return (unsigned)__builtin_amdgcn_s_getreg((3 << 11) | 20) & 0xFu; }
#define XB_SPIN(cond, bar) do { unsigned _sp = 0; while (cond) { __builtin_amdgcn_s_sleep(1); \
    if ((++_sp & 255u) == 0u) { if (xb_ld(&(bar)[XB_TMO])) break; if (_sp > XB_SPIN_CAP) { atomicAdd(&(bar)[XB_TMO], 1u); break; } } } } while (0)

struct XcdBarrier {
    unsigned* bar; unsigned x;
    volatile LAS unsigned* st;
};

__device__ __forceinline__ XcdBarrier xcd_barrier_post(unsigned* bar, volatile LAS unsigned* st) {
    XcdBarrier b; b.bar = bar; b.x = xb_xcc_id(); b.st = st;
    if (threadIdx.x == 0) (void)xb_add(&bar[XB_XCNT(b.x)], 1u);
    return b;
}
__device__ __forceinline__ void xcd_barrier_complete(unsigned* bar, unsigned x, unsigned& nloc, unsigned& nx) {
    const unsigned G = gridDim.x * gridDim.y * gridDim.z;
    unsigned sum, cnt, mine, sp = 0u;
    for (;;) {
        sum = 0u; cnt = 0u; mine = 0u;
#pragma unroll
        for (unsigned j = 0; j < 16; ++j) { const unsigned c = xb_ld(&bar[XB_XCNT(j)]); sum += c; cnt += (c > 0u) ? 1u : 0u; mine = (j == x) ? c : mine; }
        if (sum == G) break;
        __builtin_amdgcn_s_sleep(1);
        if ((++sp & 255u) == 0u) { if (xb_ld(&bar[XB_TMO])) break; if (sp > XB_SPIN_CAP) { atomicAdd(&bar[XB_TMO], 1u); break; } }
    }
    nloc = mine > 0u ? mine : 1u; nx = cnt > 0u ? cnt : 1u;
}

__device__ __forceinline__ void xcd_barrier(const XcdBarrier& b) {
    asm volatile("s_waitcnt vmcnt(0)" ::: "memory");
    __syncthreads();
    if (threadIdx.x == 0) {
        unsigned* bar = b.bar;
        __builtin_amdgcn_s_waitcnt(0);
        unsigned nloc = b.st[0], nx = b.st[1];
        if (nloc == 0u) { xcd_barrier_complete(bar, b.x, nloc, nx); b.st[0] = nloc; b.st[1] = nx; }
        const unsigned old = xb_add(&bar[XB_XSUB(b.x)], 1u);
        const unsigned gen = old / nloc;
        if (old + 1u == (gen + 1u) * nloc) {
            __builtin_amdgcn_fence(__ATOMIC_RELEASE, "agent");
            asm volatile("s_waitcnt vmcnt(0)" ::: "memory");
            const unsigned og = xb_add(&bar[XB_TOP], 1u);
            const unsigned tg = og / nx;
            if (og + 1u == (tg + 1u) * nx) xb_add(&bar[XB_TOPGEN], 1u);
            else XB_SPIN(xb_ld(&bar[XB_TOPGEN]) == tg, bar);
            __builtin_amdgcn_fence(__ATOMIC_ACQUIRE, "agent");
            xb_add(&bar[XB_XGEN(b.x)], 1u);
            asm volatile("s_waitcnt vmcnt(0)" ::: "memory");
        } else {
            XB_SPIN(xb_ld(&bar[XB_XGEN(b.x)]) == gen, bar);
            __builtin_amdgcn_fence(__ATOMIC_ACQUIRE, "agent");
            asm volatile("s_waitcnt vmcnt(0)" ::: "memory");
        }
    }
    __syncthreads();
}

DI void unpack8(const u32x4& raw, float (&v)[8]) {
#pragma unroll
    for (int j = 0; j < 4; ++j) { v[2 * j] = bflo(raw[j]); v[2 * j + 1] = bfhi(raw[j]); }
}
DI u32x4 pack8f(const float (&v)[8]) { u32x4 o; for (int j = 0; j < 4; ++j) o[j] = pk2(v[2 * j], v[2 * j + 1]); return o; }
DI void seg_norm(float (&v)[8], const float* w, int sub, float qs) {
    float ss = 0.f;
#pragma unroll
    for (int e = 0; e < 8; ++e) ss += v[e] * v[e];
    ss += __builtin_bit_cast(float, __builtin_amdgcn_update_dpp(0, __builtin_bit_cast(int, ss), 0xB1, 0xF, 0xF, false));
    ss += __builtin_bit_cast(float, __builtin_amdgcn_update_dpp(0, __builtin_bit_cast(int, ss), 0x4E, 0xF, 0xF, false));
    ss += __builtin_bit_cast(float, __builtin_amdgcn_update_dpp(0, __builtin_bit_cast(int, ss), 0x141, 0xF, 0xF, false));
    const float rs = qs / sqrtf(ss * (1.f / 64.f) + EPS);
    const f32x4 w0 = *(const f32x4*)(w + sub * 8), w1 = *(const f32x4*)(w + sub * 8 + 4);
#pragma unroll
    for (int e = 0; e < 4; ++e) { v[e] = v[e] * rs * w0[e]; v[4 + e] = v[4 + e] * rs * w1[e]; }
}
DI void seg_rope(float (&v)[8], const float (&cs)[8], const float (&sn)[8], int sub) {
#pragma unroll
    for (int e = 0; e < 8; ++e) { const float py = __shfl_xor(v[e], 4); v[e] = (sub < 4) ? v[e] * cs[e] - py * sn[e] : py * sn[e] + v[e] * cs[e]; }
}
DI void load_rope(const float* rope, int pos, int sub, float (&cs)[8], float (&sn)[8]) {
    const f32x4* rp = (const f32x4*)(rope + ((size_t)pos * 32 + (sub & 3) * 8) * 2);
#pragma unroll
    for (int j = 0; j < 4; ++j) { const f32x4 t = rp[j]; cs[2 * j] = t.x; sn[2 * j] = t.y; cs[2 * j + 1] = t.z; sn[2 * j + 1] = t.w; }
}

DI size_t kfrag_off(int key, int sub) { return (size_t)(key >> 5) * 2048 + (sub * 32 + (key & 31)) * 8; }
#define GLD4(p) (*(const __attribute__((address_space(1))) u32x4*)(p))
#define GST4(p, v) (*(__attribute__((address_space(1))) u32x4*)(p) = (v))
DI bool post0_need(int seg) { return (seg >= 12 && seg < 21) || (seg >= 24 && seg < 27); }
DI void post0_seg(const Params& p, const u32x4 raw, int seg, int token, int sub, const float (&cs)[8], const float (&sn)[8]) {
    unsigned char* ws = p.ws;
    const int s = token & (S - 1), b = token >> 12;
    bf16_t* ptr = (bf16_t*)(ws + WS_PROJ0) + (size_t)token * PROJ_LD + seg * 64 + sub * 8;
    float v[8]; unpack8(raw, v);
    if (seg == 34) {
        float* gp = (float*)(ws + WS_GATES) + (size_t)token * 36 + sub * 8;
#pragma unroll
        for (int e = 0; e < 8; ++e) if (sub * 8 + e < 36) gp[e] = 1.0f / (1.0f + __expf(-v[e]));
        return;
    }
    if (seg >= 12 && seg < 18) {
        const int i = (seg - 12) / 3, g = (seg - 12) % 3;
        bf16_t* tb = (bf16_t*)(ws + WS_TB) + (size_t)i * CMP_ROWS_PAD * 2048;
        const int c1 = s >> 4, j1 = s & 15; const size_t rb = (size_t)(b * 3 + g) * NCMP;
        if (c1 <= 254) GST4(tb + (rb + c1) * 2048 + j1 * 64 + sub * 8, raw);
        if (c1 >= 1) GST4(tb + (rb + c1 - 1) * 2048 + (j1 + 16) * 64 + sub * 8, raw);
        return;
    }
    const float* w = p.a_q_norm; float qs = 1.0f;
    if (seg < 12) qs = SC2;
    else if (seg < 21) w = p.a_k_norm + 64;
    else if (seg < 27) w = p.a_k_norm + 128;
    else { w = p.mem_q_norm; qs = SC2; }
    seg_norm(v, w, sub, qs);
    if (seg >= 30) { GST4(ptr, pack8f(v)); return; }
    seg_rope(v, cs, sn, sub);
    if (seg < 12) GST4(ptr, pack8f(v));
    else { const int g = (seg - 18) % 6, which = (seg - 18) / 6;
        bf16_t* kf = (bf16_t*)(ws + (which ? WS_KWINF : WS_KSELF)) + (size_t)(b * 3 + g) * S * 64;
        GST4(kf + kfrag_off(s, sub), pack8f(v)); }
}
DI bool post1_need(int seg) { return seg < 8; }
DI void post1_seg(const Params& p, const u32x4 raw, int seg, int token, int sub, const float (&cs)[8], const float (&sn)[8]) {
    unsigned char* ws = p.ws;
    const int s = token & (S - 1);
    bf16_t* ptr = (bf16_t*)(ws + WS_QKV1) + (size_t)token * QKV1_LD + seg * 64 + sub * 8;
    float v[8]; unpack8(raw, v);
    const float* w = p.kv_k_norm; float qs = 1.0f;
    if (seg >= 40) { w = p.mem_q_norm + 64; qs = SC2; }
    else if (seg >= 16) { w = p.b_q_norm + ((seg - 16) >> 3) * 64; qs = SC2; }
    seg_norm(v, w, sub, qs);
    if (seg >= 40) { GST4(ptr, pack8f(v)); return; }
    seg_rope(v, cs, sn, sub);
    const u32x4 o = pack8f(v);
    if (seg >= 16) GST4(ptr, o);
    else {
        const size_t hb = (size_t)((token >> 12) * 8 + seg) * S * 64;
        GST4((bf16_t*)(ws + WS_KF1) + hb + kfrag_off(s, sub), o);
        GST4((bf16_t*)(ws + WS_KF4) + hb + (size_t)(s & 3) * (S / 4) * 64 + kfrag_off(s >> 2, sub), o);
        GST4((bf16_t*)(ws + WS_KF16) + hb + (size_t)(s & 15) * (S / 16) * 64 + kfrag_off(s >> 4, sub), o);
    }
}
template <int LAYER>
DI void post_rows(const Params& p, int gw, int NGW, int lane) {
    unsigned char* ws = p.ws;
    constexpr int NSEG = LAYER == 0 ? 36 : 44, LD = LAYER == 0 ? PROJ_LD : QKV1_LD, NCH = NSEG / 4;
    const int sub = lane & 7, tl = lane >> 3;
    for (int g8 = gw; g8 < T / 8; g8 += NGW) {
        const int token = g8 * 8 + tl;
        const bf16_t* rowl = (const bf16_t*)(ws + (LAYER == 0 ? WS_PROJ0 : WS_QKV1)) + (size_t)token * LD + sub * 8;
        float cs[8], sn[8]; load_rope((const float*)(ws + WS_ROPE), token & (S - 1), sub, cs, sn);
        u32x4 ra[4], rb[4];
#pragma unroll
        for (int j = 0; j < 4; ++j) if (LAYER == 0 ? post0_need(j) : post1_need(j)) ra[j] = GLD4(rowl + j * 64);
#pragma unroll 1
        for (int c = 0; c < NCH; c += 2) {
            if (c + 1 < NCH) {
#pragma unroll
                for (int j = 0; j < 4; ++j) { const int seg = (c + 1) * 4 + j; if (LAYER == 0 ? post0_need(seg) : post1_need(seg)) rb[j] = GLD4(rowl + seg * 64); }
            }
#pragma unroll
            for (int j = 0; j < 4; ++j) { const int seg = c * 4 + j; if (LAYER == 0) { if (post0_need(seg)) post0_seg(p, ra[j], seg, token, sub, cs, sn); } else { if (post1_need(seg)) post1_seg(p, ra[j], seg, token, sub, cs, sn); } }
            if (c + 1 >= NCH) break;
            if (c + 2 < NCH) {
#pragma unroll
                for (int j = 0; j < 4; ++j) { const int seg = (c + 2) * 4 + j; if (LAYER == 0 ? post0_need(seg) : post1_need(seg)) ra[j] = GLD4(rowl + seg * 64); }
            }
#pragma unroll
            for (int j = 0; j < 4; ++j) { const int seg = (c + 1) * 4 + j; if (LAYER == 0) { if (post0_need(seg)) post0_seg(p, rb[j], seg, token, sub, cs, sn); } else { if (post1_need(seg)) post1_seg(p, rb[j], seg, token, sub, cs, sn); } }
        }
    }
}
DI void memk_row(const Params& p, int m, int lane) {
    bf16_t* row = (bf16_t*)(p.ws + WS_MEMKV) + (size_t)m * 1024;
    const int sub = lane & 7, sgl = lane >> 3, l = sgl >> 2, mh = sgl & 3;
    bf16_t* ptr = row + l * 512 + mh * 64 + sub * 8;
    const u32x4 raw = *(const u32x4*)ptr; float v[8]; unpack8(raw, v);
    seg_norm(v, p.mem_k_norm + l * 64, sub, 1.0f);
    bf16_t* kf = (bf16_t*)(p.ws + WS_MEMKF) + (size_t)((l * 8 + (m >> 8)) * 4 + mh) * NMEM * 64;
    *(u32x4*)(kf + kfrag_off(m & 255, sub)) = pack8f(v);
}
DI void vf_load(u32x4 (&v)[8], const bf16_t* src, size_t src_rs, int lane) {
    const int sub = lane & 7, rr = lane >> 3;
#pragma unroll
    for (int i = 0; i < 8; ++i) v[i] = GLD4(src + (size_t)(i * 8 + rr) * src_rs + sub * 8);
}
DI void vf_proc(const u32x4 (&v)[8], bf16_t* dst, bf16_t* scr, int lane) {
    const int sub = lane & 7, rr = lane >> 3;
#pragma unroll
    for (int i = 0; i < 8; ++i) { const int rw = i * 8 + rr; unsigned* d = (unsigned*)(scr + rw * 66 + sub * 8); d[0] = v[i].x; d[1] = v[i].y; d[2] = v[i].z; d[3] = v[i].w; }
    LDS_WAIT();
    const int h = lane >> 5, r = lane & 31;
#pragma unroll
    for (int i = 0; i < 8; ++i) { const int blk = i & 1, si = (i >> 1) & 1, tl = i >> 2;
        const bf16_t* sp = scr + (tl * 32 + 16 * si + 4 * h) * 66 + 32 * blk + r;
        u32x4 o;
#pragma unroll
        for (int j2 = 0; j2 < 4; ++j2) { const int k0 = 8 * (j2 >> 1) + 2 * (j2 & 1); o[j2] = (unsigned)sp[k0 * 66] | ((unsigned)sp[(k0 + 1) * 66] << 16); }
        GST4(dst + (size_t)(i * 64 + lane) * 8, o); }
    LDS_WAIT();
}
DI void vf_item(const bf16_t* src, size_t src_rs, bf16_t* dst, bf16_t* scr, int lane) { u32x4 v[8]; vf_load(v, src, src_rs, lane); vf_proc(v, dst, scr, lane); }

DI void phase_post0(const Params& p, unsigned char* smem, int gw, int NGW, int wave, int lane) {
    unsigned char* ws = p.ws;
    post_rows<0>(p, gw, NGW, lane);
    bf16_t* scr = (bf16_t*)(smem + wave * 8704);
    for (int it = gw; it < 2 * 24 * 64; it += NGW) {
        const int which = it / (24 * 64), bg = (it / 64) % 24, ti = it % 64, b = bg / 3, g = bg % 3;
        const bf16_t* src = (const bf16_t*)(ws + WS_PROJ0) + ((size_t)b * S + ti * 64) * PROJ_LD + (which ? 1728 : 1344) + g * 64;
        bf16_t* dst = (bf16_t*)(ws + (which ? WS_VWINF : WS_VSELF)) + (size_t)bg * 64 * S + (size_t)ti * 4096;
        vf_item(src, PROJ_LD, dst, scr, lane);
    }
    const int gtid = gw * 64 + lane;
    if (gtid < 512) { const float* part = (const float*)(ws + WS_B1PART); float a = p.a_cmp_b1[gtid];
        for (int kc = 0; kc < 16; ++kc) a += part[kc * 512 + gtid];
        ((float*)(ws + WS_B1P))[gtid] = a; }
}
DI void phase_mempost(const Params& p, unsigned char* smem, int gw, int NGW, int wave, int lane) {
    unsigned char* ws = p.ws;
    for (int m = gw; m < NB * NMEM; m += NGW) memk_row(p, m, lane);
    bf16_t* scr = (bf16_t*)(smem + wave * 8704);
    for (int it = gw; it < 2 * 8 * 4 * 4; it += NGW) {
        const int ti = it & 3, mh = (it >> 2) & 3, b = (it >> 4) & 7, l = it >> 7;
        const bf16_t* src = (const bf16_t*)(ws + WS_MEMKV) + ((size_t)b * NMEM + ti * 64) * 1024 + l * 512 + 256 + mh * 64;
        bf16_t* dst = (bf16_t*)(ws + WS_MEMVF) + (size_t)((l * 8 + b) * 4 + mh) * 64 * NMEM + (size_t)ti * 4096;
        vf_item(src, 1024, dst, scr, lane);
    }
}
DI void phase_post1(const Params& p, unsigned char* smem, int gw, int NGW, int wave, int lane) {
    unsigned char* ws = p.ws;
    post_rows<1>(p, gw, NGW, lane);
    bf16_t* scr = (bf16_t*)(smem + wave * 8704);
    auto geo = [&](int it, const bf16_t*& src, size_t& rs, bf16_t*& dst) {
        const int gi = it / 4096, bh = (it / 64) % 64, q = it % 64, b = bh >> 3, hs = bh & 7;
        const int dil = gi == 0 ? 1 : (gi == 1 ? 4 : 16), clen = S / dil, tpc = clen / 64, rc = q / tpc, ti = q % tpc;
        src = (const bf16_t*)(ws + WS_QKV1) + ((size_t)b * S + rc + (size_t)dil * ti * 64) * QKV1_LD + 512 + hs * 64;
        dst = (bf16_t*)(ws + (gi == 0 ? WS_VF1 : (gi == 1 ? WS_VF4 : WS_VF16))) + (size_t)bh * 64 * S + ((size_t)rc * clen + ti * 64) * 64;
        rs = (size_t)dil * QKV1_LD; };
    if (gw < 3 * 64 * 64) {
        u32x4 va[8], vb[8]; const bf16_t* src; size_t rs; bf16_t* dst; int it = gw;
        geo(it, src, rs, dst); vf_load(va, src, rs, lane);
        for (;;) {
            const int nit = it + NGW; const bool hn = nit < 3 * 64 * 64;
            const bf16_t* nsrc = src; size_t nrs = rs; bf16_t* ndst = dst;
            if (hn) { geo(nit, nsrc, nrs, ndst); vf_load(vb, nsrc, nrs, lane); }
            vf_proc(va, dst, scr, lane);
            if (!hn) break;
#pragma unroll
            for (int i = 0; i < 8; ++i) va[i] = vb[i];
            it = nit; dst = ndst; src = nsrc; rs = nrs;
        }
    }
}
DI size_t vfrag_off(int key, int d) { const int kk = key & 31, si = kk >> 4, q = kk & 15, j = (q >> 3) * 4 + (q & 3), h = (q >> 2) & 1;
    return (size_t)(key >> 5) * 2048 + ((((si * 2 + (d >> 5)) * 2 + h) * 32 + (d & 31)) * 8 + j); }
DI void phase_cmp2(const Params& p, int gw, int NGW, int lane) {
    unsigned char* ws = p.ws;
    for (int it = gw; it < 2 * CMP_ROWS; it += NGW) {
        const int i = __builtin_amdgcn_readfirstlane(it / CMP_ROWS), rowi = __builtin_amdgcn_readfirstlane(it % CMP_ROWS);
        const int bg = rowi / NCMP, c = rowi % NCMP;
        const unsigned* hid = (const unsigned*)((const bf16_t*)(ws + WS_HID) + ((size_t)i * CMP_ROWS_PAD + rowi) * 256);
        const float* w2 = p.a_cmp_w2 + (size_t)i * 256 * 64 + lane;
        float acc = p.a_cmp_b2[i * 64 + lane], acc1 = 0.f, acc2 = 0.f, acc3 = 0.f;
#pragma unroll 4
        for (int k2 = 0; k2 < 128; k2 += 2) { const unsigned hv = hid[k2], hw = hid[k2 + 1];
            acc += bflo(hv) * w2[(2 * k2) * 64]; acc1 += bfhi(hv) * w2[(2 * k2 + 1) * 64];
            acc2 += bflo(hw) * w2[(2 * k2 + 2) * 64]; acc3 += bfhi(hw) * w2[(2 * k2 + 3) * 64]; }
        acc = (acc + acc1) + (acc2 + acc3);
        if (i == 0) {
            const float ss = wave_sum(acc * acc);
            float y = acc * (1.0f / sqrtf(ss * (1.f / 64.f) + EPS)) * p.a_k_norm[lane];
            const float* rp = (const float*)(ws + WS_ROPE) + ((size_t)(c * 16 + 31) * 32 + (lane & 31)) * 2;
            const float py = __shfl_xor(y, 32);
            y = (lane < 32) ? y * rp[0] - py * rp[1] : py * rp[1] + y * rp[0];
            bf16_t* kc = (bf16_t*)(ws + WS_KCF) + (size_t)bg * 256 * 64;
            kc[kfrag_off(c, lane >> 3) + (lane & 7)] = (bf16_t)f2bf(y);
            if (c == NCMP - 1) kc[kfrag_off(255, lane >> 3) + (lane & 7)] = 0;
        } else {
            bf16_t* vcf = (bf16_t*)(ws + WS_VCF) + (size_t)bg * 64 * 256;
            vcf[vfrag_off(c, lane)] = (bf16_t)f2bf(acc);
            if (c == NCMP - 1) vcf[vfrag_off(255, lane)] = 0;
        }
    }
}
struct Tile { int ko; int vo; int aux; };
#define GLD8(p) (*(const __attribute__((address_space(1))) bf16x8*)(p))
DI float rowmax16(const f32x16& s) {
    float r, t1, t2, t3, t4;
    asm("s_nop 7\n\ts_nop 7\n\t"
        "v_max3_f32 %0, %5, %6, %7\n\tv_max3_f32 %1, %8, %9, %10\n\tv_max3_f32 %2, %11, %12, %13\n\tv_max3_f32 %3, %14, %15, %16\n\tv_max3_f32 %4, %17, %18, %19\n\t"
        "v_max3_f32 %0, %0, %1, %2\n\tv_max3_f32 %3, %3, %4, %20\n\tv_max_f32 %0, %0, %3"
        : "=&v"(r), "=&v"(t1), "=&v"(t2), "=&v"(t3), "=&v"(t4)
        : "v"(s[0]), "v"(s[1]), "v"(s[2]), "v"(s[3]), "v"(s[4]), "v"(s[5]), "v"(s[6]), "v"(s[7]), "v"(s[8]), "v"(s[9]), "v"(s[10]), "v"(s[11]), "v"(s[12]), "v"(s[13]), "v"(s[14]), "v"(s[15]));
    return r;
}
template <bool FAST> struct FSx { float m, l; f32x16 o0, o1; static constexpr bool fast = FAST; };
template <class ST> DI void fs_init(ST& st) { st.m = ST::fast ? 0.f : -1e30f; st.l = 0.f; st.o0 = zero16(); st.o1 = zero16(); }
DI void load_q(bf16x8 (&qf)[4], const bf16_t* qrow, int h) {
#pragma unroll
    for (int ks = 0; ks < 4; ++ks) qf[ks] = GLD8(qrow + 16 * ks + 8 * h);
}
template <bool ROPE>
DI void load_q_norm(bf16x8 (&qf)[4], const bf16_t* qrow, const float* w, const float* rope_row, int h) {
    float v[4][8];
#pragma unroll
    for (int ks = 0; ks < 4; ++ks) { const u32x4 raw = *(const __attribute__((address_space(1))) u32x4*)(qrow + 16 * ks + 8 * h);
#pragma unroll
        for (int jj = 0; jj < 4; ++jj) { v[ks][2 * jj] = bflo(raw[jj]); v[ks][2 * jj + 1] = bfhi(raw[jj]); } }
    float ss = 0.f;
#pragma unroll
    for (int ks = 0; ks < 4; ++ks)
#pragma unroll
        for (int e = 0; e < 8; ++e) ss += v[ks][e] * v[ks][e];
    ss += __shfl_xor(ss, 32);
    const float rs = SC2 / sqrtf(ss * (1.f / 64.f) + EPS);
#pragma unroll
    for (int ks = 0; ks < 4; ++ks) { const f32x4 w0 = *(const f32x4*)(w + 16 * ks + 8 * h), w1 = *(const f32x4*)(w + 16 * ks + 8 * h + 4);
#pragma unroll
        for (int e = 0; e < 4; ++e) { v[ks][e] *= rs * w0[e]; v[ks][4 + e] *= rs * w1[e]; } }
    if (ROPE) {
#pragma unroll
        for (int hf = 0; hf < 2; ++hf) { const f32x4* rp = (const f32x4*)(rope_row + 2 * (16 * hf + 8 * h));
#pragma unroll
            for (int jj = 0; jj < 4; ++jj) { const f32x4 cs = rp[jj];
                { const float x1 = v[hf][2 * jj], x2 = v[hf + 2][2 * jj]; v[hf][2 * jj] = x1 * cs.x - x2 * cs.y; v[hf + 2][2 * jj] = x1 * cs.y + x2 * cs.x; }
                { const float x1 = v[hf][2 * jj + 1], x2 = v[hf + 2][2 * jj + 1]; v[hf][2 * jj + 1] = x1 * cs.z - x2 * cs.w; v[hf + 2][2 * jj + 1] = x1 * cs.w + x2 * cs.z; } } }
    }
#pragma unroll
    for (int ks = 0; ks < 4; ++ks) qf[ks] = __builtin_bit_cast(bf16x8, pack8f(v[ks]));
}
typedef float f32x2 __attribute__((ext_vector_type(2)));
template <class ST, class Mask>
DI void attend_tile(ST& st, const bf16x8 (&qf)[4], const bf16x8 (&kf)[4], const bf16x8 (&vf)[4], Mask& mask, int aux, int h) {
    f32x16 s = zero16();
#pragma unroll
    for (int ks = 0; ks < 4; ++ks) s = MFMA32(kf[ks], qf[ks], s);
    if (!mask.full(aux)) {
        const int d = mask.prep(aux);
#pragma unroll
        for (int i = 0; i < 16; ++i) s[i] = mask.elem(d, (i & 3) + 8 * (i >> 2)) ? s[i] : -INFINITY;
    }
    const bool on = mask.lane(aux);
    if constexpr (ST::fast) {
        f32x2 acc2 = {0.f, 0.f};
#pragma unroll
        for (int i = 0; i < 8; ++i) { f32x2 v; v.x = __builtin_amdgcn_exp2f(s[2 * i]); v.y = __builtin_amdgcn_exp2f(s[2 * i + 1]); s[2 * i] = v.x; s[2 * i + 1] = v.y; acc2 = acc2 + v; }
        st.l += on ? (acc2.x + acc2.y) : 0.f;
        const unsigned onm = on ? 0xffffffffu : 0u;
#pragma unroll
        for (int si = 0; si < 2; ++si) {
            u32x4 w = __builtin_bit_cast(u32x4, pack8(s, si)); w = w & onm;
            const bf16x8 pb = __builtin_bit_cast(bf16x8, w);
            st.o0 = MFMA32(vf[si * 2], pb, st.o0);
            st.o1 = MFMA32(vf[si * 2 + 1], pb, st.o1);
        }
        return;
    }
    float mx = rowmax16(s);
    mx = on ? mx : -INFINITY;
    if (__any(mx > st.m + 6.0f)) {
        mx = fmaxf(mx, __shfl_xor(mx, 32));
        const float mn = fmaxf(st.m, mx);
        const float alpha = __builtin_amdgcn_exp2f(st.m - mn);
        st.m = mn; st.l *= alpha; st.o0 = st.o0 * alpha; st.o1 = st.o1 * alpha;
    }
    const float msub = on ? st.m : INFINITY;
    f32x2 acc2 = {0.f, 0.f};
#pragma unroll
    for (int i = 0; i < 8; ++i) {
        f32x2 v = {s[2 * i], s[2 * i + 1]}; v = v - msub;
        v.x = __builtin_amdgcn_exp2f(v.x); v.y = __builtin_amdgcn_exp2f(v.y);
        s[2 * i] = v.x; s[2 * i + 1] = v.y; acc2 = acc2 + v;
    }
    st.l += acc2.x + acc2.y;
#pragma unroll
    for (int si = 0; si < 2; ++si) {
        const bf16x8 pb = pack8(s, si);
        st.o0 = MFMA32(vf[si * 2], pb, st.o0);
        st.o1 = MFMA32(vf[si * 2 + 1], pb, st.o1);
    }
}
DI void load_k(bf16x8 (&kf)[4], const bf16_t* kb, const Tile& t) {
#pragma unroll
    for (int q = 0; q < 4; ++q) kf[q] = GLD8(kb + t.ko + 512 * q);
}
DI void load_v(bf16x8 (&vf)[4], const bf16_t* vb, const Tile& t) {
#pragma unroll
    for (int q = 0; q < 4; ++q) vf[q] = GLD8(vb + t.vo + 512 * q);
}
template <class ST, class Next, class Mask>
DI void attend(ST& st, const bf16x8 (&qf)[4], const bf16_t* kb, const bf16_t* vb, Next& next, Mask& mask, int h) {
    Tile ta, tb;
    if (!next(ta)) return;
    bf16x8 kA[4], kB[4], vf[4];
    load_k(kA, kb, ta);
    for (;;) {
        const bool hb = next(tb);
        load_v(vf, vb, ta);
        if (hb) load_k(kB, kb, tb);
        attend_tile(st, qf, kA, vf, mask, ta.aux, h);
        if (!hb) break;
        const bool ha = next(ta);
        load_v(vf, vb, tb);
        if (ha) load_k(kA, kb, ta);
        attend_tile(st, qf, kB, vf, mask, tb.aux, h);
        if (!ha) break;
    }
}
template <class ST> DI float fs_inv(ST& st) { const float l = st.l + __shfl_xor(st.l, 32); return l > 0.f ? 1.0f / l : 0.f; }
DI void store_o(bf16_t* orow, const f32x16& a0, const f32x16& a1, int h) {
#pragma unroll
    for (int g = 0; g < 4; ++g) {
        u32x2 w0; w0.x = pk2(a0[4 * g], a0[4 * g + 1]); w0.y = pk2(a0[4 * g + 2], a0[4 * g + 3]);
        u32x2 w1; w1.x = pk2(a1[4 * g], a1[4 * g + 1]); w1.y = pk2(a1[4 * g + 2], a1[4 * g + 3]);
        *(__attribute__((address_space(1))) u32x2*)(orow + 8 * g + 4 * h) = w0; *(__attribute__((address_space(1))) u32x2*)(orow + 32 + 8 * g + 4 * h) = w1;
    }
}

template <bool FAST>
DI void mem_item(const Params& p, int layer, int it, int lane) {
    unsigned char* ws = p.ws;
    const int r = lane & 31, h = lane >> 5;
    const int tile = it & 127, mh = (it >> 7) & 3, b = it >> 9;
    const size_t tok = (size_t)b * S + tile * 32 + r;
    const bf16_t* qrow = layer == 0 ? (const bf16_t*)(ws + WS_PROJ0) + tok * PROJ_LD + 1920 + mh * 64 : (const bf16_t*)(ws + WS_QKV1) + tok * QKV1_LD + 2560 + mh * 64;
    bf16x8 qf[4]; load_q_norm<false>(qf, qrow, p.mem_q_norm + layer * 64, nullptr, h);
    const bf16_t* kb = (const bf16_t*)(ws + WS_MEMKF) + (size_t)((layer * 8 + b) * 4 + mh) * NMEM * 64 + lane * 8;
    const bf16_t* vb = (const bf16_t*)(ws + WS_MEMVF) + (size_t)((layer * 8 + b) * 4 + mh) * NMEM * 64 + lane * 8;
    int ti = 0;
    auto next = [&](Tile& t) -> bool { if (ti >= 8) return false; t.ko = ti * 2048; t.vo = ti * 2048; t.aux = 0; ++ti; return true; };
    struct { DI bool full(int) const { return true; } DI bool lane(int) const { return true; } DI int prep(int) const { return 0; } DI bool elem(int, int) const { return true; } } mask;
    FSx<FAST> st; fs_init(st);
    attend(st, qf, kb, vb, next, mask, h);
    const float inv = fs_inv(st);
    bf16_t* orow = layer == 0 ? (bf16_t*)(ws + WS_ATT0) + tok * 1024 + 768 + mh * 64 : (bf16_t*)(ws + WS_ATT1) + tok * 768 + 512 + mh * 64;
    store_o(orow, st.o0 * inv, st.o1 * inv, h);
}

template <class ST> DI void softmax_p(ST& st, f32x16& s, bf16x8 (&pk)[2], bool on) {
    if constexpr (ST::fast) {
        f32x2 acc2 = {0.f, 0.f};
#pragma unroll
        for (int i = 0; i < 8; ++i) { f32x2 v; v.x = __builtin_amdgcn_exp2f(s[2 * i]); v.y = __builtin_amdgcn_exp2f(s[2 * i + 1]); s[2 * i] = v.x; s[2 * i + 1] = v.y; acc2 = acc2 + v; }
        st.l += on ? (acc2.x + acc2.y) : 0.f;
        const unsigned onm = on ? 0xffffffffu : 0u;
#pragma unroll
        for (int si = 0; si < 2; ++si) { u32x4 w = __builtin_bit_cast(u32x4, pack8(s, si)); w = w & onm; pk[si] = __builtin_bit_cast(bf16x8, w); }
        return;
    }
    float mx = rowmax16(s);
    mx = on ? mx : -INFINITY;
    if (__any(mx > st.m + 6.0f)) {
        mx = fmaxf(mx, __shfl_xor(mx, 32));
        const float mn = fmaxf(st.m, mx);
        const float alpha = __builtin_amdgcn_exp2f(st.m - mn);
        st.m = mn; st.l *= alpha; st.o0 = st.o0 * alpha; st.o1 = st.o1 * alpha;
    }
    const float msub = on ? st.m : INFINITY;
    f32x2 acc2 = {0.f, 0.f};
#pragma unroll
    for (int i = 0; i < 8; ++i) {
        f32x2 v = {s[2 * i], s[2 * i + 1]}; v = v - msub;
        v.x = __builtin_amdgcn_exp2f(v.x); v.y = __builtin_amdgcn_exp2f(v.y);
        s[2 * i] = v.x; s[2 * i + 1] = v.y; acc2 = acc2 + v;
    }
    st.l += acc2.x + acc2.y;
#pragma unroll
    for (int si = 0; si < 2; ++si) pk[si] = pack8(s, si);
}
template <class ST> DI void pv_acc(ST& st, const bf16x8 (&pk)[2], const bf16x8 (&vf)[4]) {
#pragma unroll
    for (int si = 0; si < 2; ++si) { st.o0 = MFMA32(vf[si * 2], pk[si], st.o0); st.o1 = MFMA32(vf[si * 2 + 1], pk[si], st.o1); }
}
template <class ST, class Next, class Mask>
DI void attend2(ST& s0, ST& s1, const bf16x8 (&q0)[4], const bf16x8 (&q1)[4], const bf16_t* kb, const bf16_t* vb, Next& next, Mask& mask) {
    Tile cur;
    if (!next(cur)) return;
    bf16x8 kf[4], vf[4];
    load_k(kf, kb, cur);
    for (;;) {
        Tile nx; const bool hn = next(nx);
        load_v(vf, vb, cur);
        f32x16 sa = zero16(), sb = zero16();
#pragma unroll
        for (int ks = 0; ks < 4; ++ks) { sa = MFMA32(kf[ks], q0[ks], sa); sb = MFMA32(kf[ks], q1[ks], sb); }
        if (hn) load_k(kf, kb, nx);
        if (!mask.full(cur.aux)) {
            const int d = mask.prep(cur.aux);
#pragma unroll
            for (int i = 0; i < 16; ++i) { const bool ok = mask.elem(d, (i & 3) + 8 * (i >> 2)); sa[i] = ok ? sa[i] : -INFINITY; sb[i] = ok ? sb[i] : -INFINITY; }
        }
        const bool on = mask.lane(cur.aux);
        bf16x8 pa[2], pb[2];
        softmax_p(s0, sa, pa, on);
        softmax_p(s1, sb, pb, on);
        pv_acc(s0, pa, vf);
        pv_acc(s1, pb, vf);
        if (!hn) break;
        cur = nx;
    }
}
DI void rmw_o(bf16_t* orow, const f32x16& a0, const f32x16& a1, int h, bool first) {
#pragma unroll
    for (int g = 0; g < 4; ++g) {
        __attribute__((address_space(1))) u32x2* p0 = (__attribute__((address_space(1))) u32x2*)(orow + 8 * g + 4 * h);
        __attribute__((address_space(1))) u32x2* p1 = (__attribute__((address_space(1))) u32x2*)(orow + 32 + 8 * g + 4 * h);
        float b0[4] = {0.f, 0.f, 0.f, 0.f}, b1[4] = {0.f, 0.f, 0.f, 0.f};
        if (!first) { const u32x2 x0 = *p0, x1 = *p1; b0[0] = bflo(x0.x); b0[1] = bfhi(x0.x); b0[2] = bflo(x0.y); b0[3] = bfhi(x0.y); b1[0] = bflo(x1.x); b1[1] = bfhi(x1.x); b1[2] = bflo(x1.y); b1[3] = bfhi(x1.y); }
        u32x2 w0; w0.x = pk2(a0[4 * g] + b0[0], a0[4 * g + 1] + b0[1]); w0.y = pk2(a0[4 * g + 2] + b0[2], a0[4 * g + 3] + b0[3]);
        u32x2 w1; w1.x = pk2(a1[4 * g] + b1[0], a1[4 * g + 1] + b1[1]); w1.y = pk2(a1[4 * g + 2] + b1[2], a1[4 * g + 3] + b1[3]);
        *p0 = w0; *p1 = w1;
    }
}

template <bool FAST>
DI void nsa_item2(const Params& p, unsigned char* smem, int c64, int bg, bool valid, int w4, int slot, int lane) {
    unsigned char* ws = p.ws;
    const int b = bg / 3, g = bg % 3;
    const int r = lane & 31, h = lane >> 5, qh = w4 >> 1, hp = w4 & 1, head0 = g * 4 + hp * 2;
    const int t0 = c64 * 64 + qh * 32, t = t0 + r;
    const size_t tok = (size_t)b * S + t;
    const bf16_t* proj = (const bf16_t*)(ws + WS_PROJ0);
    float* imp = (float*)(smem + slot * 33792);
    u64* selmask = (u64*)(smem + 2 * 33792 + slot * 512);
    bf16x8 q0[4], q1[4];
    { const float* rr = (const float*)(ws + WS_ROPE) + (size_t)t * 64;
      load_q_norm<true>(q0, proj + tok * PROJ_LD + head0 * 64, p.a_q_norm, rr, h); load_q_norm<true>(q1, proj + tok * PROJ_LD + head0 * 64 + 64, p.a_q_norm, rr, h); }
    const bf16_t* gp = proj + tok * PROJ_LD + 2176 + head0 * 3;
    float gt[6];
#pragma unroll
    for (int i = 0; i < 6; ++i) gt[i] = 1.0f / (1.0f + __expf(-bf2f(gp[i])));
    const float gc0 = gt[0], gs0 = gt[1], gw0 = gt[2], gc1 = gt[3], gs1 = gt[4], gw1 = gt[5];
    bf16_t* orow = (bf16_t*)(ws + WS_ATT0) + tok * 1024 + head0 * 64;
    if (valid) {
        const bf16_t* kcb = (const bf16_t*)(ws + WS_KCF) + (size_t)bg * 256 * 64 + lane * 8;
        const bf16_t* vcb = (const bf16_t*)(ws + WS_VCF) + (size_t)bg * 256 * 64 + lane * 8;
        int ncv = t0 / 16 + 1; if (ncv > NCMP) ncv = NCMP;
        const int nct = (ncv + 31) >> 5;
        float m0 = -1e30f, l0 = 0.f, m1 = -1e30f, l1 = 0.f;
        bf16x8 kc[4], kn[4];
#pragma unroll
        for (int ks = 0; ks < 4; ++ks) kc[ks] = GLD8(kcb + 512 * ks);
#pragma unroll 1
        for (int ct = 0; ct < nct; ++ct) {
            const int cn = ct + 1 < nct ? ct + 1 : 0;
#pragma unroll
            for (int ks = 0; ks < 4; ++ks) kn[ks] = GLD8(kcb + cn * 2048 + 512 * ks);
            f32x16 sa = zero16(), sb = zero16();
#pragma unroll
            for (int ks = 0; ks < 4; ++ks) { sa = MFMA32(kc[ks], q0[ks], sa); sb = MFMA32(kc[ks], q1[ks], sb); }
#pragma unroll
            for (int ks = 0; ks < 4; ++ks) kc[ks] = kn[ks];
            float mxa = -INFINITY, mxb = -INFINITY;
#pragma unroll
            for (int i = 0; i < 16; ++i) { const int c = ct * 32 + crow(i, h); const bool ok = (c * 16 + 31 <= t); sa[i] = ok ? sa[i] : -INFINITY; sb[i] = ok ? sb[i] : -INFINITY; mxa = fmaxf(mxa, sa[i]); mxb = fmaxf(mxb, sb[i]); }
            mxa = fmaxf(mxa, __shfl_xor(mxa, 32)); mxb = fmaxf(mxb, __shfl_xor(mxb, 32));
            const float mna = fmaxf(m0, mxa), mnb = fmaxf(m1, mxb);
            float lsa = 0.f, lsb = 0.f;
#pragma unroll
            for (int i = 0; i < 16; ++i) { lsa += __builtin_amdgcn_exp2f(sa[i] - mna); lsb += __builtin_amdgcn_exp2f(sb[i] - mnb); }
            l0 = l0 * __builtin_amdgcn_exp2f(m0 - mna) + lsa; m0 = mna;
            l1 = l1 * __builtin_amdgcn_exp2f(m1 - mnb) + lsb; m1 = mnb;
        }
        l0 += __shfl_xor(l0, 32); l1 += __shfl_xor(l1, 32);
        const float il0 = l0 > 0.f ? 1.0f / l0 : 0.f, il1 = l1 > 0.f ? 1.0f / l1 : 0.f;
        f32x16 oa0 = zero16(), oa1 = zero16(), ob0 = zero16(), ob1 = zero16();
        float carry = 0.f;
        float* impw = imp + ((hp * 2 + qh) * 32 + r) * 65;
#pragma unroll 1
        for (int ct = 0; ct < 8; ++ct) {
            if (ct < nct) {
                bf16x8 vc[4];
#pragma unroll
                for (int q = 0; q < 4; ++q) vc[q] = GLD8(vcb + ct * 2048 + 512 * q);
                const int cn = ct + 1 < nct ? ct + 1 : ct;
#pragma unroll
                for (int ks = 0; ks < 4; ++ks) kn[ks] = GLD8(kcb + cn * 2048 + 512 * ks);
                f32x16 sa = zero16(), sb = zero16();
#pragma unroll
                for (int ks = 0; ks < 4; ++ks) { sa = MFMA32(kc[ks], q0[ks], sa); sb = MFMA32(kc[ks], q1[ks], sb); }
#pragma unroll
                for (int ks = 0; ks < 4; ++ks) kc[ks] = kn[ks];
#pragma unroll
                for (int i = 0; i < 16; ++i) { const int c = ct * 32 + crow(i, h); const bool ok = (c * 16 + 31 <= t);
                    sa[i] = ok ? __builtin_amdgcn_exp2f(sa[i] - m0) : 0.f; sb[i] = ok ? __builtin_amdgcn_exp2f(sb[i] - m1) : 0.f; }
#pragma unroll
                for (int si = 0; si < 2; ++si) {
                    const bf16x8 pa = pack8(sa, si), pb = pack8(sb, si);
                    oa0 = MFMA32(vc[2 * si], pa, oa0); oa1 = MFMA32(vc[2 * si + 1], pa, oa1);
                    ob0 = MFMA32(vc[2 * si], pb, ob0); ob1 = MFMA32(vc[2 * si + 1], pb, ob1);
                }
#pragma unroll
                for (int i = 0; i < 16; ++i) sa[i] = sa[i] * il0 + sb[i] * il1;
                float y3[4];
#pragma unroll
                for (int q = 0; q < 4; ++q) y3[q] = __shfl_xor(sa[4 * q + 3], 32);
#pragma unroll
                for (int q = 0; q < 4; ++q) {
                    const float quad = (sa[4 * q] + sa[4 * q + 1]) + (sa[4 * q + 2] + sa[4 * q + 3]);
                    const float prev = h ? y3[q] : (q ? y3[q > 0 ? q - 1 : 0] : carry);
                    impw[ct * 8 + 2 * q + h] = quad + prev;
                }
                carry = y3[3];
            } else {
#pragma unroll
                for (int q = 0; q < 4; ++q) impw[ct * 8 + 2 * q + h] = 0.f;
            }
        }
        const float f0 = gc0 * il0, f1 = gc1 * il1;
        rmw_o(orow, oa0 * f0, oa1 * f0, h, true);
        rmw_o(orow + 64, ob0 * f1, ob1 * f1, h, true);
    }
    __syncthreads();
    if (valid) {
        const int cur = c64, j = lane;
#pragma unroll 1
        for (int n0 = 0; n0 < 16; n0 += 4) {
            float v[4]; unsigned key[4], thr[4];
#pragma unroll
            for (int u = 0; u < 4; ++u) {
                const int tq = w4 * 16 + n0 + u, qh2 = tq >> 5, r2 = tq & 31;
                float x = imp[((0 * 2 + qh2) * 32 + r2) * 65 + j] + imp[((1 * 2 + qh2) * 32 + r2) * 65 + j];
                const bool forced = (j == 0) || (j == cur) || (j == cur - 1);
                x = forced ? 1e9f : (j <= cur ? x : -1e30f);
                v[u] = x;
                const unsigned vb = __builtin_bit_cast(unsigned, x); key[u] = (vb & 0x80000000u) ? ~vb : (vb | 0x80000000u); thr[u] = 0u;
            }
#pragma unroll
            for (int bit = 31; bit >= 0; --bit) {
#pragma unroll
                for (int u = 0; u < 4; ++u) { const unsigned cand = thr[u] | (1u << bit); if (__builtin_popcountll(__ballot(key[u] >= cand)) >= 16) thr[u] = cand; }
            }
#pragma unroll
            for (int u = 0; u < 4; ++u) {
                const u64 gt = __ballot(key[u] > thr[u]), eq = __ballot(key[u] == thr[u]);
                const int need = 16 - __builtin_popcountll(gt);
                const int eqrank = __builtin_popcountll(eq & ((1ull << j) - 1ull));
                const bool sel = ((key[u] > thr[u]) || (key[u] == thr[u] && eqrank < need)) && (v[u] > -5e29f);
                const u64 mk = __ballot(sel);
                if (lane == 0) selmask[w4 * 16 + n0 + u] = mk;
            }
        }
    }
    __syncthreads();
    if (valid) {
        {
            const u64 mym = selmask[qh * 32 + r];
            unsigned ulo = (unsigned)mym, uhi = (unsigned)(mym >> 32);
#pragma unroll
            for (int o = 1; o < 32; o <<= 1) { ulo |= __shfl_xor(ulo, o); uhi |= __shfl_xor(uhi, o); }
            u64 un = ((u64)(unsigned)__builtin_amdgcn_readfirstlane(uhi) << 32) | (unsigned)__builtin_amdgcn_readfirstlane(ulo);
            int sub = 0;
            const bf16_t* kb = (const bf16_t*)(ws + WS_KSELF) + (size_t)bg * S * 64 + lane * 8;
            const bf16_t* vb = (const bf16_t*)(ws + WS_VSELF) + (size_t)bg * S * 64 + lane * 8;
            auto next = [&](Tile& tl) -> bool {
                if (!un) return false;
                const int jb = __builtin_ctzll(un); const int pb = jb * 64 + sub * 32;
                tl.ko = pb * 64; tl.vo = pb * 64; tl.aux = pb;
                if (sub == 1 || pb + 32 > t0 + 31) { un &= un - 1; sub = 0; } else sub = 1;
                return true; };
            struct M { u64 mym; int th, t0; DI bool full(int pb) const { return pb + 31 <= t0; } DI bool lane(int pb) const { return (mym >> (pb >> 6)) & 1ull; } DI int prep(int pb) const { return th - pb; } DI bool elem(int d, int ci) const { return ci <= d; } } mask{mym, t - 4 * h, t0};
            FSx<FAST> s0, s1; fs_init(s0); fs_init(s1);
            attend2(s0, s1, q0, q1, kb, vb, next, mask);
            const float f0 = gs0 * fs_inv(s0), f1 = gs1 * fs_inv(s1);
            rmw_o(orow, s0.o0 * f0, s0.o1 * f0, h, false);
            rmw_o(orow + 64, s1.o0 * f1, s1.o1 * f1, h, false);
        }
        {
            int wt = (t0 >= 512 ? t0 - 512 : 0) >> 5; const int wend = t0 >> 5;
            const bf16_t* kb = (const bf16_t*)(ws + WS_KWINF) + (size_t)bg * S * 64 + lane * 8;
            const bf16_t* vb = (const bf16_t*)(ws + WS_VWINF) + (size_t)bg * S * 64 + lane * 8;
            auto next = [&](Tile& tl) -> bool { if (wt > wend) return false; const int pb = wt * 32; tl.ko = pb * 64; tl.vo = pb * 64; tl.aux = pb; ++wt; return true; };
            struct M { int th, t0; DI bool full(int pb) const { return pb + 31 <= t0 && pb >= t0 - 480; } DI bool lane(int) const { return true; } DI int prep(int pb) const { return th - pb; } DI bool elem(int d, int ci) const { return (unsigned)(d - ci) < 512u; } } mask{t - 4 * h, t0};
            FSx<FAST> s0, s1; fs_init(s0); fs_init(s1);
            attend2(s0, s1, q0, q1, kb, vb, next, mask);
            const float f0 = gw0 * fs_inv(s0), f1 = gw1 * fs_inv(s1);
            rmw_o(orow, s0.o0 * f0, s0.o1 * f0, h, false);
            rmw_o(orow + 64, s1.o0 * f1, s1.o1 * f1, h, false);
        }
    }
    __syncthreads();
}
template <bool FAST>
DI void phase_attn0_t(const Params& p, unsigned char* smem, int bid, int G, int wave, int lane) {
    const int slot = wave >> 2, w4 = wave & 3;
    if (wave >= 4) __builtin_amdgcn_s_setprio(1);
    if (G == 256) {
        const int xcd = bid & 7, l = bid >> 3;
        for (int rd = 0; rd < 3; ++rd) {
            int k = l;
            if (rd == 1) k = l < 16 ? 31 - 2 * l : 2 * (31 - l);
            else if (rd == 2) k = l == 0 ? 31 : (l < 16 ? l + 15 : l - 16);
            nsa_item2<FAST>(p, smem, 63 - (2 * k + slot), xcd + 8 * rd, true, w4, slot, lane);
        }
    } else {
        for (int rd = 0; rd * 2 * G < 1536; ++rd) {
            const int pr = rd * G + ((rd & 1) ? (G - 1 - bid) : bid), it = 2 * pr + slot;
            const bool valid = it < 1536; const int itc = valid ? it : 0;
            nsa_item2<FAST>(p, smem, 63 - itc / 24, itc % 24, valid, w4, slot, lane);
        }
    }
    const int gw = bid * 8 + wave, NGW = G * 8;
    for (int it = gw; it < 4096; it += NGW) mem_item<FAST>(p, 0, it, lane);
    __builtin_amdgcn_s_setprio(0);
}
DI void phase_attn0(const Params& p, unsigned char* smem, int bid, int G, int wave, int lane) {
    const bool fast = __builtin_amdgcn_readfirstlane(*(const int*)(p.ws + WS_FLAG)) != 0;
    if (fast) phase_attn0_t<true>(p, smem, bid, G, wave, lane); else phase_attn0_t<false>(p, smem, bid, G, wave, lane);
}

template <int GI, class ST>
DI void dil_group(const Params& p, ST& st, int b, int hs, int sp, int r16, int lane) {
    unsigned char* ws = p.ws;
    constexpr int dil = GI == 0 ? 1 : (GI == 1 ? 4 : 16), clen = S / dil;
    const int r = lane & 31, h = lane >> 5;
    const int t = sp * 512 + r16 + 16 * r, rc = r16 % dil, qc = t / dil;
    const bf16_t* qkv = (const bf16_t*)(ws + WS_QKV1);
    bf16x8 qf[4]; load_q_norm<true>(qf, qkv + ((size_t)b * S + t) * QKV1_LD + 1024 + GI * 512 + hs * 64, p.b_q_norm + GI * 64, (const float*)(ws + WS_ROPE) + (size_t)t * 64, h);
    const int cbase = sp * 512 / dil;
    int ti = (cbase >= 128 ? cbase - 128 : 0) >> 5; const int tend = (cbase + 512 / dil - 1) >> 5;
    const size_t cb = (size_t)(b * 8 + hs) * S * 64 + (size_t)rc * clen * 64 + lane * 8;
    const bf16_t* kb = (const bf16_t*)(ws + (GI == 0 ? WS_KF1 : (GI == 1 ? WS_KF4 : WS_KF16))) + cb;
    const bf16_t* vb = (const bf16_t*)(ws + (GI == 0 ? WS_VF1 : (GI == 1 ? WS_VF4 : WS_VF16))) + cb;
    auto next = [&](Tile& tl) -> bool { if (ti > tend) return false; const int k0 = ti * 32; tl.ko = k0 * 64; tl.vo = k0 * 64; tl.aux = k0; ++ti; return true; };
    struct M { int qh, lo, hi; DI bool full(int k0) const { return k0 >= lo && k0 <= hi; } DI bool lane(int) const { return true; } DI int prep(int k0) const { return qh - k0; } DI bool elem(int d, int ci) const { return (unsigned)(d - ci) <= 128u; } } mask{qc - 4 * h, GI == 2 ? sp * 32 - 97 : 1, GI == 2 ? sp * 32 - 31 : 0};
    attend(st, qf, kb, vb, next, mask, h);
}
template <int GI, bool FAST>
DI void dil_pass_a(const Params& p, bf16_t* os, float* lses, int b, int hs, int sp, int qt, int lane) {
    unsigned char* ws = p.ws;
    constexpr int dil = GI == 0 ? 1 : 4, clen = S / dil, nq = 16 / dil;
    const int r = lane & 31, h = lane >> 5;
    const int rc = qt / nq, qi = qt % nq;
    const int c0 = sp * (512 / dil) + qi * 32, qc = c0 + r;
    const int tl = rc + dil * (qi * 32 + r), t = sp * 512 + tl;
    const bf16_t* qkv = (const bf16_t*)(ws + WS_QKV1);
    bf16x8 qf[4]; load_q_norm<true>(qf, qkv + ((size_t)b * S + t) * QKV1_LD + 1024 + GI * 512 + hs * 64, p.b_q_norm + GI * 64, (const float*)(ws + WS_ROPE) + (size_t)t * 64, h);
    const size_t cb = (size_t)(b * 8 + hs) * S * 64 + (size_t)rc * clen * 64 + lane * 8;
    const bf16_t* kb = (const bf16_t*)(ws + (GI == 0 ? WS_KF1 : WS_KF4)) + cb; const bf16_t* vb = (const bf16_t*)(ws + (GI == 0 ? WS_VF1 : WS_VF4)) + cb;
    int k0 = c0 >= 128 ? c0 - 128 : 0;
    auto next = [&](Tile& tile) -> bool { if (k0 > c0) return false; tile.ko = k0 * 64; tile.vo = k0 * 64; tile.aux = k0; k0 += 32; return true; };
    struct M { int th, c0; DI bool full(int kk) const { return kk + 31 <= c0 && kk >= c0 - 96; } DI bool lane(int) const { return true; } DI int prep(int kk) const { return th - kk; } DI bool elem(int d, int ci) const { return (unsigned)(d - ci) <= 128u; } } mask{qc - 4 * h, c0};
    FSx<FAST> st; fs_init(st);
    attend(st, qf, kb, vb, next, mask, h);
    const float l = st.l + __shfl_xor(st.l, 32);
    const float inv = 1.0f / l;
    if (h == 0) lses[tl] = st.m + __builtin_amdgcn_logf(l);
    bf16_t* orow = os + tl * 68;
#pragma unroll
    for (int g = 0; g < 4; ++g) {
        u32x2 w0; w0.x = pk2(st.o0[4 * g] * inv, st.o0[4 * g + 1] * inv); w0.y = pk2(st.o0[4 * g + 2] * inv, st.o0[4 * g + 3] * inv);
        u32x2 w1; w1.x = pk2(st.o1[4 * g] * inv, st.o1[4 * g + 1] * inv); w1.y = pk2(st.o1[4 * g + 2] * inv, st.o1[4 * g + 3] * inv);
        *(u32x2*)(orow + 8 * g + 4 * h) = w0; *(u32x2*)(orow + 32 + 8 * g + 4 * h) = w1;
    }
}
template <bool FAST>
DI void dil_span_item(const Params& p, unsigned char* smem, int it, int wave, int lane) {
    unsigned char* ws = p.ws;
    const int sp = it & 7, hs = (it >> 3) & 7, b = it >> 6;
    const int r = lane & 31, h = lane >> 5;
    bf16_t* o0s = (bf16_t*)smem;
    bf16_t* o1s = (bf16_t*)(smem + 512 * 136);
    float* lse0 = (float*)(smem + 2 * 512 * 136);
    float* lse1 = lse0 + 512;
#pragma unroll 1
    for (int u = 0; u < 2; ++u) dil_pass_a<0, FAST>(p, o0s, lse0, b, hs, sp, wave * 2 + u, lane);
#pragma unroll 1
    for (int u = 0; u < 2; ++u) dil_pass_a<1, FAST>(p, o1s, lse1, b, hs, sp, wave * 2 + u, lane);
    __syncthreads();
#pragma unroll 1
    for (int u = 0; u < 2; ++u) {
        const int r16 = wave * 2 + u, tl = r16 + 16 * r, t = sp * 512 + tl;
        FSx<FAST> st; fs_init(st);
        dil_group<2>(p, st, b, hs, sp, r16, lane);
        const float l2 = st.l + __shfl_xor(st.l, 32);
        const float x2 = st.m + __builtin_amdgcn_logf(l2), x0 = lse0[tl], x1 = lse1[tl];
        const float mm = fmaxf(fmaxf(x0, x1), x2), e0 = __builtin_amdgcn_exp2f(x0 - mm), e1 = __builtin_amdgcn_exp2f(x1 - mm), e2 = __builtin_amdgcn_exp2f(x2 - mm), rden = 1.0f / (e0 + e1 + e2);
        const float a0 = e0 * rden, a1 = e1 * rden, a2 = e2 * rden / l2;
        const bf16_t* ra = o0s + tl * 68; const bf16_t* rb = o1s + tl * 68;
        f32x16 r0, r1;
#pragma unroll
        for (int g = 0; g < 4; ++g) {
            const u32x2 x0a = *(const u32x2*)(ra + 8 * g + 4 * h), x1a = *(const u32x2*)(ra + 32 + 8 * g + 4 * h);
            const u32x2 x0b = *(const u32x2*)(rb + 8 * g + 4 * h), x1b = *(const u32x2*)(rb + 32 + 8 * g + 4 * h);
            r0[4 * g] = st.o0[4 * g] * a2 + bflo(x0a.x) * a0 + bflo(x0b.x) * a1; r0[4 * g + 1] = st.o0[4 * g + 1] * a2 + bfhi(x0a.x) * a0 + bfhi(x0b.x) * a1;
            r0[4 * g + 2] = st.o0[4 * g + 2] * a2 + bflo(x0a.y) * a0 + bflo(x0b.y) * a1; r0[4 * g + 3] = st.o0[4 * g + 3] * a2 + bfhi(x0a.y) * a0 + bfhi(x0b.y) * a1;
            r1[4 * g] = st.o1[4 * g] * a2 + bflo(x1a.x) * a0 + bflo(x1b.x) * a1; r1[4 * g + 1] = st.o1[4 * g + 1] * a2 + bfhi(x1a.x) * a0 + bfhi(x1b.x) * a1;
            r1[4 * g + 2] = st.o1[4 * g + 2] * a2 + bflo(x1a.y) * a0 + bflo(x1b.y) * a1; r1[4 * g + 3] = st.o1[4 * g + 3] * a2 + bfhi(x1a.y) * a0 + bfhi(x1b.y) * a1;
        }
        store_o((bf16_t*)(ws + WS_ATT1) + ((size_t)b * S + t) * 768 + hs * 64, r0, r1, h);
    }
    __syncthreads();
}
template <bool FAST>
DI void phase_attn1_t(const Params& p, unsigned char* smem, int bid, int G, int wave, int lane) {
    const int gw = bid * 8 + wave, NGW = G * 8;
    if (wave >= 4) __builtin_amdgcn_s_setprio(1);
    if (G == 256) {
        const int xcd = bid & 7, l = bid >> 3;
        for (int rd = 0; rd < 2; ++rd) { const int bh = rd * 32 + xcd * 4 + (l >> 3); dil_span_item<FAST>(p, smem, bh * 8 + (l & 7), wave, lane); }
    } else {
        for (int it = bid; it < 512; it += G) dil_span_item<FAST>(p, smem, it, wave, lane);
    }
    for (int it = gw; it < 4096; it += NGW) mem_item<FAST>(p, 1, it, lane);
    __builtin_amdgcn_s_setprio(0);
}
DI void phase_attn1(const Params& p, unsigned char* smem, int bid, int G, int wave, int lane) {
    const bool fast = __builtin_amdgcn_readfirstlane(*(const int*)(p.ws + WS_FLAG)) != 0;
    if (fast) phase_attn1_t<true>(p, smem, bid, G, wave, lane); else phase_attn1_t<false>(p, smem, bid, G, wave, lane);
}
__global__ void __launch_bounds__(512, 2) yoco_fwd(Params pk) {
    extern __shared__ __attribute__((aligned(16))) unsigned char smem[];
    cg::grid_group grid = cg::this_grid();
    const int tid = threadIdx.x, lane = tid & 63, wave = __builtin_amdgcn_readfirstlane(tid >> 6);
    const int bid = blockIdx.x, G = gridDim.x, gw = bid * 8 + wave, NGW = G * 8;
    unsigned char* const ws = pk.ws;
    PG8_LAS unsigned char* lds = (PG8_LAS unsigned char*)smem;
    bf16_t* const Hb = (bf16_t*)(ws + WS_H);
    volatile LAS unsigned* misc = (volatile LAS unsigned*)((LAS unsigned char*)smem + LDS_MISC);
    if (tid < 2) misc[tid] = 0u;
    __syncthreads();
    const XcdBarrier xbar = xcd_barrier_post((unsigned*)(ws + WS_BAR), misc);
#define GSYNC() xcd_barrier(xbar)
#define GEMM_STORE(ACT, Aptr, Bptr, M_, N_, K_, Optr, LDC, BIAS) do { pg8::Gemm g{(const bf16_t*)(Aptr), (const bf16_t*)(Bptr), (M_), (N_), (K_)}; \
        pg8::EpiStore<ACT> E; E.O = (bf16_t*)(Optr); E.ldc = (LDC); E.bias = nullptr; E.rowss = (BIAS); pg8::StaticOrder So; So.init((M_), (N_), G, bid); \
        pg8::gemm_phase<pg8::EpiStore<ACT>, pg8::StaticOrder, true, true>(lds, g, So, E); } while (0)
#define GEMM_RES(Aptr, Bptr, K_, BASEF, BASEH, OUTF, HB, HB2, RSS) do { LDP(); pg8::Gemm g{(const bf16_t*)(Aptr), (const bf16_t*)(Bptr), T, DM, (K_)}; \
        pg8::EpiRes E; E.basef = (BASEF); E.baseh = (BASEH); E.outf = (OUTF); E.ldc = DM; E.hb = (HB); E.hb2 = (HB2); E.rowss = (RSS); pg8::StaticOrder So; So.init(T, DM, G, bid); \
        pg8::gemm_phase<pg8::EpiRes, pg8::StaticOrder, true, true>(lds, g, So, E); } while (0)
    float* const RS0 = (float*)(ws + WS_RSS);
#define NOF ((float*)nullptr)
#define NOH ((bf16_t*)nullptr)
    { if (bid == 0 && tid < (int)(sizeof(Params) / 8)) ((u64*)(ws + WS_PARAMS))[tid] = ((const u64*)&pk)[tid];
      phase_prep(pk, smem, gw, NGW, wave, lane); }
    if (pk.ws == nullptr) grid.sync();
    GSYNC();
#define LDP() const Params p = *(const Params*)(ws + WS_PARAMS)
    GEMM_STORE(0, Hb, ws + WS_WAIN, T, PROJ_LD, DM, ws + WS_PROJ0, PROJ_LD, nullptr);
    GSYNC();
    { LDP(); phase_post0(p, smem, gw, NGW, wave, lane); }
    GSYNC();
    if (G >= 80) {
        if (bid < 48) {
            const int i = bid / 24;
            pg8::Gemm g{(const bf16_t*)(ws + WS_TB) + (size_t)i * CMP_ROWS_PAD * 2048, (const bf16_t*)(ws + WS_WC1) + (size_t)i * 2048 * 256, CMP_ROWS_PAD, 256, 2048};
            pg8::EpiStore<1> E; E.O = (bf16_t*)(ws + WS_HID) + (size_t)i * CMP_ROWS_PAD * 256; E.ldc = 256; E.bias = (const float*)(ws + WS_B1P) + i * 256; E.rowss = nullptr;
            pg8::StaticOrder So; So.init(CMP_ROWS_PAD, 256, 24, bid - 24 * i);
            pg8::gemm_phase<pg8::EpiStore<1>, pg8::StaticOrder, true, true>(lds, g, So, E);
        } else if (bid < 80) {
            pg8::Gemm g{(const bf16_t*)(ws + WS_MEMN), (const bf16_t*)(ws + WS_WMKV), NB * NMEM, 1024, DM};
            pg8::EpiStore<0> E; E.O = (bf16_t*)(ws + WS_MEMKV); E.ldc = 1024; E.bias = nullptr; E.rowss = nullptr;
            pg8::StaticOrder So; So.init(NB * NMEM, 1024, 32, bid - 48);
            pg8::gemm_phase<pg8::EpiStore<0>, pg8::StaticOrder, true, true>(lds, g, So, E);
        } else { LDP(); prep_weights_b(p, smem, (bid - 80) * 8 + wave, (G - 80) * 8, wave, lane); }
    } else {
        { LDP(); prep_weights_b(p, smem, gw, NGW, wave, lane); }
        for (int i = 0; i < 2; ++i) {
            pg8::Gemm g{(const bf16_t*)(ws + WS_TB) + (size_t)i * CMP_ROWS_PAD * 2048, (const bf16_t*)(ws + WS_WC1) + (size_t)i * 2048 * 256, CMP_ROWS_PAD, 256, 2048};
            pg8::EpiStore<1> E; E.O = (bf16_t*)(ws + WS_HID) + (size_t)i * CMP_ROWS_PAD * 256; E.ldc = 256; E.bias = (const float*)(ws + WS_B1P) + i * 256; E.rowss = nullptr;
            pg8::StaticOrder So; So.init(CMP_ROWS_PAD, 256, G, bid);
            pg8::gemm_phase<pg8::EpiStore<1>, pg8::StaticOrder, true, true>(lds, g, So, E);
        }
        GEMM_STORE(0, ws + WS_MEMN, ws + WS_WMKV, NB * NMEM, 1024, DM, ws + WS_MEMKV, 1024, nullptr);
    }
    GSYNC();
    { LDP(); phase_cmp2(p, gw, NGW, lane); phase_mempost(p, smem, gw, NGW, wave, lane); }
    GSYNC();
    { LDP(); phase_attn0(p, smem, bid, G, wave, lane); }
    GSYNC();
    GEMM_RES(ws + WS_ATT0, ws + WS_WAOUT, 1024, p.x, NOH, NOF, Hb, NOH, RS0);
    GSYNC();
    GEMM_STORE(2, Hb, ws + WS_WUP, T, FF, DM, ws + WS_U, FF, RS0);
    GSYNC();
    GEMM_RES(ws + WS_U, ws + WS_WDN, FF, NOF, Hb, NOF, Hb, (bf16_t*)p.out, RS0 + T);
    GSYNC();
    GEMM_STORE(0, Hb, ws + WS_WKVB, T, QKV1_LD, DM, ws + WS_QKV1, QKV1_LD, RS0 + T);
    GSYNC();
    { LDP(); phase_post1(p, smem, gw, NGW, wave, lane); }
    GSYNC();
    { LDP(); phase_attn1(p, smem, bid, G, wave, lane); }
    GSYNC();
    GEMM_RES(ws + WS_ATT1, ws + WS_WBOUT, 768, NOF, (const bf16_t*)p.out, NOF, Hb, NOH, RS0 + 2 * T);
    GSYNC();
    GEMM_STORE(2, Hb, (const bf16_t*)(ws + WS_WUP) + (size_t)DM * FF, T, FF, DM, ws + WS_U, FF, RS0 + 2 * T);
    GSYNC();
    GEMM_RES(ws + WS_U, (const bf16_t*)(ws + WS_WDN) + (size_t)DM * FF, FF, NOF, Hb, p.out, NOH, NOH, NOF);
}

extern "C" void kernel_launch(void* const* d_in, const int* in_sizes, int n_in, void* d_out, int out_size, void* d_ws, size_t ws_size, hipStream_t stream) {
    static int grid = 0;
    if (grid == 0) {
        if (n_in != 25 || out_size != T * DM || ws_size < WS_END) { fprintf(stderr, "kernel_launch: unexpected problem (n_in %d, out %d, ws %zu)\n", n_in, out_size, ws_size); grid = -1; return; }
        int dev = 0, cus = 0, per_cu = 0;
        hipGetDevice(&dev); hipDeviceGetAttribute(&cus, hipDeviceAttributeMultiprocessorCount, dev);
        if (hipFuncSetAttribute((const void*)yoco_fwd, hipFuncAttributeMaxDynamicSharedMemorySize, LDS_BYTES) != hipSuccess) { fprintf(stderr, "kernel_launch: hipFuncSetAttribute failed\n"); grid = -1; return; }
        if (hipOccupancyMaxActiveBlocksPerMultiprocessor(&per_cu, (const void*)yoco_fwd, 512, LDS_BYTES) != hipSuccess || per_cu < 1) { fprintf(stderr, "kernel_launch: occupancy query says %d blocks/CU\n", per_cu); (void)hipGetLastError(); per_cu = 1; }
        grid = cus * 1;
        if (grid <= 0) grid = 256;
    }
    if (grid < 0) return;
    if (hipMemsetAsync((char*)d_ws + WS_BAR, 0, BAR_BYTES, stream) != hipSuccess) { fprintf(stderr, "kernel_launch: memset failed\n"); return; }
    Params p{};
    const float** pp = (const float**)&p;
    for (int i = 0; i < 25; ++i) pp[i] = (const float*)d_in[i];
    p.out = (float*)d_out; p.ws = (unsigned char*)d_ws;
    void* args[] = {&p};
    hipError_t e = hipLaunchCooperativeKernel((const void*)yoco_fwd, dim3(grid), dim3(512), args, LDS_BYTES, stream);
    if (e != hipSuccess) fprintf(stderr, "cooperative launch failed: %s (grid %d)\n", hipGetErrorString(e), grid);
}
```

```cpp
#include <hip/hip_runtime.h>
#include <hip/hip_cooperative_groups.h>
#include <cstdio>
#include <cstdint>
namespace cg = cooperative_groups;
namespace pg8 {
#define PG8_LAS __attribute__((address_space(3)))
typedef unsigned short bf16_t;
typedef short bf16x8 __attribute__((ext_vector_type(8)));
typedef float f32x4 __attribute__((ext_vector_type(4)));
typedef unsigned u32x4 __attribute__((ext_vector_type(4)));
constexpr int BM = 256, BK = 64, HALF = 128, HTB = HALF * BK * 2  , STAGE_BYTES = 8 * HTB, NXCD = 8, WGM = 8;

__host__ __device__ __forceinline__ int lds_byte(int r, int c) { const int st = (r >> 4) * 2 + (c >> 5), rr = r & 15, cc = c & 31, ob = rr * 64 + cc * 2; return st * 1024 + (ob ^ (((ob >> 9) & 1) << 5)); }
__host__ __device__ __forceinline__ void stage_rc(int b, int& R, int& C) { const int st = b / 1024, sb = b % 1024, swz = sb ^ (((sb >> 9) & 1) << 5); R = (st >> 1) * 16 + swz / 64; C = (st & 1) * 32 + (swz % 64) / 2; }
__host__ __device__ __forceinline__ int perm32(int rho) { const int n = rho >> 4, i = rho & 15; return 8 * (i >> 2) + 4 * n + (i & 3); }

struct Unit { int pm, pn; };
struct Gemm { const bf16_t* A; const bf16_t* Bt; int M, N, K; };

struct StaticOrder {
    int nM, nN, nwg, G, c;
    __host__ __device__ void init(int M, int N, int G_, int c_) { nM = M / BM; nN = N / BM; nwg = nM * nN; G = G_; c = c_; }
    __host__ __device__ bool next(int i, Unit& u) const {
        const long L = (long)i * G + c; if (L >= nwg) return false;
        int wgid = (int)L; { const int q = nwg / NXCD, r = nwg % NXCD, xcd = wgid % NXCD, off = wgid / NXCD; wgid = (xcd < r ? xcd * (q + 1) : r * (q + 1) + (xcd - r) * q) + off; }
        const int nig = WGM * nN, gid = wgid / nig, fm = gid * WGM, gsz = (nM - fm) < WGM ? (nM - fm) : WGM;
        u.pm = fm + ((wgid % nig) % gsz); u.pn = (wgid % nig) / gsz; return true;
    }
    __device__ __forceinline__ void a_ready(const Unit&) const {}
    __device__ __forceinline__ void done(const Unit&) const {}
};

__device__ __forceinline__ unsigned cvt_pk_bf16(float lo, float hi) { unsigned r; asm volatile("v_cvt_pk_bf16_f32 %0, %1, %2" : "=v"(r) : "v"(lo), "v"(hi)); return r; }
__device__ __forceinline__ float gelu_tanh(float x) {
    const float u = 0.7978845608028654f * (x + 0.044715f * x * x * x);
    const float e = __builtin_amdgcn_exp2f(u * 2.885390081777927f);
    const float th = 1.0f - 2.0f * __builtin_amdgcn_rcpf(1.0f + e);
    return 0.5f * x * (1.0f + th);
}
template <int ACT> struct EpiStore {
    static constexpr bool PERM = true, AFTER_DRAIN = false;
    bf16_t* O; int ldc; const float* bias; const float* rowss;
    __device__ __forceinline__ void operator()(const f32x4 (&acc)[2][2][4][2], const Unit& u, int wr, int wc, int fr, int fq) const {
        const int row0 = u.pm * BM + wr * 64 + fr; const int col0 = u.pn * BM + wc * 32 + 8 * fq;
        f32x4 bv[2][2];
#pragma unroll
        for (int bj = 0; bj < 2; ++bj)
#pragma unroll
            for (int n = 0; n < 2; ++n) bv[bj][n] = (ACT == 1) ? *(const f32x4*)(bias + col0 + bj * HALF + 4 * n) : (f32x4){0.f, 0.f, 0.f, 0.f};
#pragma unroll
        for (int ai = 0; ai < 2; ++ai)
#pragma unroll
            for (int m = 0; m < 4; ++m) { bf16_t* rowp = O + (size_t)(row0 + ai * HALF + m * 16) * ldc + col0;
                float rs = 1.0f; if (rowss) rs = 1.0f / sqrtf(rowss[row0 + ai * HALF + m * 16] * (1.0f / 1024.0f) + 1e-6f);
                if (ACT == 2) rs = rs * rs;
#pragma unroll
                for (int bj = 0; bj < 2; ++bj) { f32x4 v0 = acc[ai][bj][m][0], v1 = acc[ai][bj][m][1];
                    if (ACT == 1) { v0 = v0 + bv[bj][0]; v1 = v1 + bv[bj][1];
#pragma unroll
                        for (int e = 0; e < 4; ++e) { v0[e] = gelu_tanh(v0[e]); v1[e] = gelu_tanh(v1[e]); } }
                    if (ACT == 2) {
#pragma unroll
                        for (int e = 0; e < 4; ++e) { float a = fmaxf(v0[e], 0.f), b = fmaxf(v1[e], 0.f); v0[e] = a * a; v1[e] = b * b; } }
                    v0 = v0 * rs; v1 = v1 * rs;
                    u32x4 w; w.x = cvt_pk_bf16(v0[0], v0[1]); w.y = cvt_pk_bf16(v0[2], v0[3]); w.z = cvt_pk_bf16(v1[0], v1[1]); w.w = cvt_pk_bf16(v1[2], v1[3]);
                    *(u32x4*)(rowp + bj * HALF) = w; } }
    }
};
struct EpiRes {
    static constexpr bool PERM = true, AFTER_DRAIN = false;
    const float* basef; const bf16_t* baseh; float* outf; int ldc; bf16_t* hb; bf16_t* hb2; float* rowss;
    __device__ __forceinline__ void operator()(const f32x4 (&acc)[2][2][4][2], const Unit& u, int wr, int wc, int fr, int fq) const {
        const int row0 = u.pm * BM + wr * 64 + fr; const int col0 = u.pn * BM + wc * 32 + 8 * fq;
        float ss[8];
#pragma unroll
        for (int ai = 0; ai < 2; ++ai)
#pragma unroll
            for (int m = 0; m < 4; ++m) { const size_t off = (size_t)(row0 + ai * HALF + m * 16) * ldc + col0;
                float ssq = 0.f;
#pragma unroll
                for (int bj = 0; bj < 2; ++bj) {
                    f32x4 b0, b1;
                    if (basef) { b0 = *(const f32x4*)(basef + off + bj * HALF); b1 = *(const f32x4*)(basef + off + bj * HALF + 4); }
                    else { const u32x4 r = *(const u32x4*)(baseh + off + bj * HALF);
                        b0 = (f32x4){__builtin_bit_cast(float, r.x << 16), __builtin_bit_cast(float, r.x & 0xffff0000u), __builtin_bit_cast(float, r.y << 16), __builtin_bit_cast(float, r.y & 0xffff0000u)};
                        b1 = (f32x4){__builtin_bit_cast(float, r.z << 16), __builtin_bit_cast(float, r.z & 0xffff0000u), __builtin_bit_cast(float, r.w << 16), __builtin_bit_cast(float, r.w & 0xffff0000u)}; }
                    const f32x4 n0 = b0 + acc[ai][bj][m][0], n1 = b1 + acc[ai][bj][m][1];
                    if (outf) { *(f32x4*)(outf + off + bj * HALF) = n0; *(f32x4*)(outf + off + bj * HALF + 4) = n1; }
                    if (hb) { ssq += (n0[0] * n0[0] + n0[1] * n0[1]) + (n0[2] * n0[2] + n0[3] * n0[3]) + (n1[0] * n1[0] + n1[1] * n1[1]) + (n1[2] * n1[2] + n1[3] * n1[3]);
                        u32x4 w; w.x = cvt_pk_bf16(n0[0], n0[1]); w.y = cvt_pk_bf16(n0[2], n0[3]); w.z = cvt_pk_bf16(n1[0], n1[1]); w.w = cvt_pk_bf16(n1[2], n1[3]);
                        *(u32x4*)(hb + off + bj * HALF) = w; if (hb2) *(u32x4*)(hb2 + off + bj * HALF) = w; } }
                if (hb) { ssq += __shfl_xor(ssq, 16); ssq += __shfl_xor(ssq, 32); }
                ss[ai * 4 + m] = ssq; }
        if (hb) {
            const float va = fq == 0 ? ss[0] : (fq == 1 ? ss[1] : (fq == 2 ? ss[2] : ss[3]));
            const float vb = fq == 0 ? ss[4] : (fq == 1 ? ss[5] : (fq == 2 ? ss[6] : ss[7]));
            (void)__hip_atomic_fetch_add(rowss + row0 + fq * 16, va, __ATOMIC_RELAXED, __HIP_MEMORY_SCOPE_AGENT);
            (void)__hip_atomic_fetch_add(rowss + row0 + HALF + fq * 16, vb, __ATOMIC_RELAXED, __HIP_MEMORY_SCOPE_AGENT);
        }
    }
};
template <class Epi, class Sched, bool ALIGN_EPI = false, bool SP2 = false>
__device__ __forceinline__ void gemm_phase(PG8_LAS unsigned char* lds, const Gemm g, const Sched& S, const Epi& E) {
    int tid_ = threadIdx.x; asm volatile("" : "+v"(tid_));
    const int tid = tid_, wid = __builtin_amdgcn_readfirstlane(tid >> 6), lane = tid & 63, wr = wid >> 2, wc = wid & 3, fr = lane & 15, fq = lane >> 4;
    const int K = g.K, nt = K / BK;
    unsigned voffA[2], voffB[2];
#pragma unroll
    for (int i = 0; i < 2; ++i) { int R, C; stage_rc(tid * 16 + i * 8192, R, C); const int Rb = Epi::PERM ? ((R & ~31) + perm32(R & 31)) : R;
        voffA[i] = (unsigned)(R * K + C) * 2u; voffB[i] = (unsigned)(Rb * K + C) * 2u; }
    const size_t kstep = (size_t)(BK * 2);
    const size_t hstep = (size_t)HALF * K * 2;
    const size_t tstep = 2 * hstep;
    const unsigned ldsw = (unsigned)wid * 1024u;
    const int aoff = lds_byte(wr * 64 + fr, fq * 8), boff = lds_byte(wc * 32 + fr, fq * 8);
#define PG8_SA(b, h) (((b) * 2 + (h)) * HTB)
#define PG8_SB(b, h) ((4 + (b) * 2 + (h)) * HTB)
#define PG8_STAGE(bufoff, gbase, voff) do { _Pragma("unroll") for (int _i = 0; _i < 2; ++_i) \
        __builtin_amdgcn_global_load_lds((const unsigned*)((const char*)(gbase) + (voff)[_i]), (PG8_LAS unsigned*)(lds + (bufoff) + ldsw + _i * 8192), 16, 0, 0); } while (0)
#define PG8_LDA(dst, b, h) do { _Pragma("unroll") for (int m = 0; m < 4; ++m) _Pragma("unroll") for (int k = 0; k < 2; ++k) dst[m][k] = *(const PG8_LAS bf16x8*)(lds + PG8_SA(b, h) + aoff + m * 2048 + k * 1024); } while (0)
#define PG8_LDB(dst, b, h) do { _Pragma("unroll") for (int n = 0; n < 2; ++n) _Pragma("unroll") for (int k = 0; k < 2; ++k) dst[n][k] = *(const PG8_LAS bf16x8*)(lds + PG8_SB(b, h) + boff + n * 2048 + k * 1024); } while (0)
#define PG8_MMA(ai, bj, At, Bt) do { __builtin_amdgcn_s_setprio(1); _Pragma("unroll") for (int m = 0; m < 4; ++m) _Pragma("unroll") for (int n = 0; n < 2; ++n) _Pragma("unroll") for (int k = 0; k < 2; ++k) \
        acc[ai][bj][m][n] = __builtin_amdgcn_mfma_f32_16x16x32_bf16(Bt[n][k], At[m][k], acc[ai][bj][m][n], 0, 0, 0); __builtin_amdgcn_s_setprio(0); } while (0)
#define PG8_WAIT_V(n) asm volatile("s_waitcnt vmcnt(" #n ")" ::: "memory")
#define PG8_WAIT_L(n) asm volatile("s_waitcnt lgkmcnt(" #n ")" ::: "memory")
#define PG8_BAR __builtin_amdgcn_s_barrier()
#define PG8_SCHED __builtin_amdgcn_sched_barrier(0)
    Unit cur, nxt; int ui = 0;
    if (!S.next(0, cur)) return;
    f32x4 acc[2][2][4][2];
#pragma unroll
    for (int a = 0; a < 2; ++a)
#pragma unroll
        for (int b = 0; b < 2; ++b)
#pragma unroll
            for (int m = 0; m < 4; ++m)
#pragma unroll
                for (int n = 0; n < 2; ++n) acc[a][b][m][n] = (f32x4){0.f, 0.f, 0.f, 0.f};
    bf16x8 At[4][2], B0[2][2], B1[2][2];
    const char* cA = (const char*)g.A + (size_t)cur.pm * tstep; const char* cB = (const char*)g.Bt + (size_t)cur.pn * tstep;
    S.a_ready(cur);
    if constexpr (SP2) {
        PG8_STAGE(PG8_SB(0, 0), cB, voffB); PG8_STAGE(PG8_SB(0, 1), cB + hstep, voffB); PG8_STAGE(PG8_SA(0, 0), cA, voffA); PG8_STAGE(PG8_SA(0, 1), cA + hstep, voffA);
        if (wr == 1) PG8_BAR;
        PG8_WAIT_V(2); PG8_BAR;
        PG8_STAGE(PG8_SB(1, 0), cB + kstep, voffB); PG8_STAGE(PG8_SA(1, 0), cA + kstep, voffA); PG8_STAGE(PG8_SB(1, 1), cB + hstep + kstep, voffB);
        PG8_WAIT_V(6); PG8_BAR;
    } else {
        PG8_STAGE(PG8_SB(0, 0), cB, voffB); PG8_STAGE(PG8_SA(0, 0), cA, voffA); PG8_STAGE(PG8_SB(0, 1), cB + hstep, voffB); PG8_STAGE(PG8_SA(0, 1), cA + hstep, voffA);
        if (wr == 1) PG8_BAR;
        PG8_WAIT_V(4); PG8_BAR;
        PG8_STAGE(PG8_SB(1, 0), cB + kstep, voffB); PG8_STAGE(PG8_SA(1, 0), cA + kstep, voffA); PG8_STAGE(PG8_SB(1, 1), cB + hstep + kstep, voffB);
        PG8_WAIT_V(6); PG8_BAR;
    }
    for (;;) {
        const bool has_next = S.next(ui + 1, nxt);
        const char* nA = has_next ? (const char*)g.A + (size_t)nxt.pm * tstep : cA; const char* nB = has_next ? (const char*)g.Bt + (size_t)nxt.pn * tstep : cB;
        for (int t = 0; t < nt; t += 2) {
            const bool last = (t == nt - 2);
            const char* a1 = cA + (size_t)(t + 1) * kstep;
            const char* a2 = last ? nA : cA + (size_t)(t + 2) * kstep; const char* b2 = last ? nB : cB + (size_t)(t + 2) * kstep;
            const char* a3 = a2 + kstep; const char* b3 = b2 + kstep;
            if (last && has_next) S.a_ready(nxt);
            if constexpr (SP2) {
            PG8_LDB(B0, 0, 0); PG8_LDB(B1, 0, 1); PG8_SCHED; PG8_LDA(At, 0, 0); PG8_STAGE(PG8_SA(1, 1), a1 + hstep, voffA);
            PG8_WAIT_V(8); PG8_WAIT_L(0); PG8_BAR; PG8_MMA(0, 0, At, B0); PG8_MMA(0, 1, At, B1); PG8_BAR; PG8_SCHED;
            PG8_LDA(At, 0, 1); PG8_STAGE(PG8_SB(0, 0), b2, voffB); PG8_STAGE(PG8_SB(0, 1), b2 + hstep, voffB); PG8_STAGE(PG8_SA(0, 0), a2, voffA);
            PG8_WAIT_V(8); PG8_WAIT_L(0); PG8_BAR; PG8_MMA(1, 0, At, B0); PG8_MMA(1, 1, At, B1); PG8_BAR; PG8_SCHED;
            PG8_LDB(B0, 1, 0); PG8_LDB(B1, 1, 1); PG8_SCHED; PG8_LDA(At, 1, 0); PG8_STAGE(PG8_SA(0, 1), a2 + hstep, voffA);
            PG8_WAIT_V(8); PG8_WAIT_L(0); PG8_BAR; PG8_MMA(0, 0, At, B0); PG8_MMA(0, 1, At, B1); PG8_BAR; PG8_SCHED;
            PG8_LDA(At, 1, 1); PG8_STAGE(PG8_SB(1, 0), b3, voffB); PG8_STAGE(PG8_SB(1, 1), b3 + hstep, voffB); PG8_STAGE(PG8_SA(1, 0), a3, voffA);
            PG8_WAIT_V(8); PG8_WAIT_L(0); PG8_BAR; PG8_MMA(1, 0, At, B0); PG8_MMA(1, 1, At, B1); PG8_BAR; PG8_SCHED;
            } else {
            PG8_LDB(B0, 0, 0); PG8_SCHED; PG8_LDA(At, 0, 0); PG8_STAGE(PG8_SA(1, 1), a1 + hstep, voffA);
            PG8_WAIT_L(8); PG8_BAR; PG8_WAIT_L(0); PG8_MMA(0, 0, At, B0); PG8_BAR; PG8_SCHED;
            PG8_LDB(B1, 0, 1); PG8_STAGE(PG8_SB(0, 0), b2, voffB);
            PG8_BAR; PG8_WAIT_L(0); PG8_MMA(0, 1, At, B1); PG8_BAR;
            PG8_LDA(At, 0, 1); PG8_STAGE(PG8_SA(0, 0), a2, voffA);
            PG8_BAR; PG8_WAIT_L(0); PG8_MMA(1, 0, At, B0); PG8_BAR; PG8_SCHED;
            PG8_STAGE(PG8_SB(0, 1), b2 + hstep, voffB);
            PG8_WAIT_V(6); PG8_BAR; PG8_MMA(1, 1, At, B1); PG8_BAR;
            PG8_LDB(B0, 1, 0); PG8_SCHED; PG8_LDA(At, 1, 0); PG8_STAGE(PG8_SA(0, 1), a2 + hstep, voffA);
            PG8_WAIT_L(8); PG8_BAR; PG8_WAIT_L(0); PG8_MMA(0, 0, At, B0); PG8_BAR; PG8_SCHED;
            PG8_LDB(B1, 1, 1); PG8_STAGE(PG8_SB(1, 0), b3, voffB);
            PG8_BAR; PG8_WAIT_L(0); PG8_MMA(0, 1, At, B1); PG8_BAR;
            PG8_LDA(At, 1, 1); PG8_STAGE(PG8_SA(1, 0), a3, voffA);
            PG8_BAR; PG8_WAIT_L(0); PG8_MMA(1, 0, At, B0); PG8_BAR; PG8_SCHED;
            PG8_STAGE(PG8_SB(1, 1), b3 + hstep, voffB);
            PG8_WAIT_V(6); PG8_BAR; PG8_MMA(1, 1, At, B1); PG8_BAR;
            }
        }
        if constexpr (ALIGN_EPI) { if (wr == 0) PG8_BAR; }
        if constexpr (!Epi::AFTER_DRAIN) { E(acc, cur, wr, wc, fr, fq); S.done(cur); }
        if (!has_next) break;
#pragma unroll
        for (int a = 0; a < 2; ++a)
#pragma unroll
            for (int b = 0; b < 2; ++b)
#pragma unroll
                for (int m = 0; m < 4; ++m)
#pragma unroll
                    for (int n = 0; n < 2; ++n) acc[a][b][m][n] = (f32x4){0.f, 0.f, 0.f, 0.f};
        cur = nxt; cA = nA; cB = nB; ++ui;
        if constexpr (ALIGN_EPI) { if (wr == 1) PG8_BAR; }
    }
    PG8_WAIT_V(0);
    if constexpr (!ALIGN_EPI) { if (wr == 0) PG8_BAR; }
    PG8_BAR;
    if constexpr (Epi::AFTER_DRAIN) { E.fused(acc, cur, wr, wc, fr, fq, lds, wid, lane); S.done(cur); }
#undef PG8_SA
#undef PG8_SB
#undef PG8_STAGE
#undef PG8_LDA
#undef PG8_LDB
#undef PG8_MMA
#undef PG8_WAIT_V
#undef PG8_WAIT_L
#undef PG8_BAR
#undef PG8_SCHED
}
}
typedef unsigned short bf16_t;
typedef short bf16x8 __attribute__((ext_vector_type(8)));
typedef short s16x4 __attribute__((ext_vector_type(4)));
typedef float f32x4 __attribute__((ext_vector_type(4)));
typedef float f32x16 __attribute__((ext_vector_type(16)));
typedef unsigned u32x4 __attribute__((ext_vector_type(4)));
typedef unsigned u32x2 __attribute__((ext_vector_type(2)));
typedef unsigned long long u64;
#define DI __device__ __forceinline__
#define MFMA32(a, b, c) __builtin_amdgcn_mfma_f32_32x32x16_bf16((a), (b), (c), 0, 0, 0)
#define LDS_WAIT() asm volatile("s_waitcnt lgkmcnt(0)" ::: "memory")

constexpr int NB = 8, S = 4096, DM = 1024, T = NB * S, FF = 4096, NMEM = 256;
constexpr int PROJ_LD = 2304, QKV1_LD = 2816, NCMP = 255, CMP_ROWS = 6120, CMP_ROWS_PAD = 6144;
constexpr float EPS = 1e-6f;
constexpr float SC2 = 0.125f * 1.4426950408889634f;
constexpr size_t MiB = 1u << 20;
constexpr size_t WS_WAIN = 0, WS_WAOUT = 5 * MiB, WS_WUP = 7 * MiB, WS_WDN = 23 * MiB, WS_WMKV = 39 * MiB, WS_WKVB = 41 * MiB, WS_WBOUT = 47 * MiB, WS_WC1 = 49 * MiB;
constexpr size_t WS_PARAMS = 51 * MiB + 32768, WS_FLAG = 51 * MiB + 32768 + 1024, WS_B1P = 51 * MiB, WS_B1PART = 51 * MiB + 65536, WS_ROPE = 52 * MiB, WS_MEMN = 53 * MiB, WS_MEMKV = 57 * MiB, WS_MEMVF = 61 * MiB, WS_HID = 63 * MiB;
constexpr size_t WS_KCF = 69 * MiB, WS_VCF = 70 * MiB, WS_GATES = 71 * MiB, WS_MEMKF = 76 * MiB;
constexpr size_t WS_H = 80 * MiB, WS_VF1 = 80 * MiB, WS_VF4 = 112 * MiB;
constexpr size_t WS_TB = 144 * MiB, WS_VF16 = 144 * MiB, WS_KF1 = 176 * MiB;
constexpr size_t WS_R1 = 208 * MiB, WS_PROJ0 = WS_R1, WS_ATT0 = WS_R1 + 144 * MiB, WS_VSELF = WS_R1 + 208 * MiB, WS_VWINF = WS_R1 + 220 * MiB, WS_KSELF = WS_R1 + 232 * MiB, WS_KWINF = WS_R1 + 244 * MiB;
constexpr size_t WS_U = WS_R1, WS_QKV1 = WS_R1, WS_ATT1 = WS_R1 + 176 * MiB, WS_KF4 = 432 * MiB, WS_KF16 = 464 * MiB, WS_END = 496 * MiB;
constexpr int LDS_BYTES = 147456, LDS_MISC = 147392;
constexpr size_t WS_BAR = 51 * MiB + 131072, BAR_BYTES = 16384, WS_RSS = 51 * MiB + 262144;

struct Params {
    const float *x, *mem, *attn_norm, *mlp_norm, *w_up, *w_down, *mem_norm, *w_mem_kv, *mem_q_norm, *mem_k_norm,
        *a_w_in, *a_w_out, *a_q_norm, *a_k_norm, *a_cmp_pos, *a_cmp_w1, *a_cmp_b1, *a_cmp_w2, *a_cmp_b2,
        *kv_norm, *w_kv_shared, *kv_k_norm, *b_w_in, *b_w_out, *b_q_norm;
    float* out; unsigned char* ws;
};

DI unsigned f2bf(float f) { unsigned u = __builtin_bit_cast(unsigned, f); return (u + 0x7fffu + ((u >> 16) & 1u)) >> 16; }
DI unsigned pk2(float lo, float hi) { return f2bf(lo) | (f2bf(hi) << 16); }
DI float bflo(unsigned u) { return __builtin_bit_cast(float, u << 16); }
DI float bfhi(unsigned u) { return __builtin_bit_cast(float, u & 0xffff0000u); }
DI float bf2f(bf16_t b) { return __builtin_bit_cast(float, (unsigned)b << 16); }
DI float wave_sum(float v) {
#pragma unroll
    for (int o = 1; o < 64; o <<= 1) v += __shfl_xor(v, o);
    return v;
}
DI int crow(int reg, int h) { return (reg & 3) + 8 * (reg >> 2) + 4 * h; }
DI f32x16 zero16() { f32x16 z; for (int i = 0; i < 16; ++i) z[i] = 0.f; return z; }
DI bf16x8 pack8(const f32x16& x, int s) {
    u32x4 p;
#pragma unroll
    for (int j = 0; j < 4; ++j) p[j] = pg8::cvt_pk_bf16(x[8 * s + 2 * j], x[8 * s + 2 * j + 1]);
    return __builtin_bit_cast(bf16x8, p);
}

DI void wt_item(const float* W, int K, int N, int nblk, const float* gain, bf16_t* WT, int row_off, float* scr, int item, int lane) {
    const int kb = item / nblk, nb = item % nblk, k0 = 64 * kb, n0 = 32 * nb;
    const int n4 = n0 + (lane & 7) * 4;
    f32x4 v[8];
#pragma unroll
    for (int i = 0; i < 8; ++i) { const int kk = i * 8 + (lane >> 3);
        v[i] = (n4 < N) ? *(const __attribute__((address_space(1))) f32x4*)(W + (size_t)(k0 + kk) * N + n4) : (f32x4){0.f, 0.f, 0.f, 0.f}; }
#pragma unroll
    for (int i = 0; i < 8; ++i) { const int kk = i * 8 + (lane >> 3); f32x4 t = v[i]; if (gain) t = t * gain[k0 + kk];
        float* d = scr + kk * 33 + (lane & 7) * 4; d[0] = t.x; d[1] = t.y; d[2] = t.z; d[3] = t.w; }
    LDS_WAIT();
    const int c = lane & 7;
#pragma unroll
    for (int j = 0; j < 4; ++j) { const int n = (lane >> 3) + 8 * j; const float* s = scr + (8 * c) * 33 + n;
        u32x4 o; o.x = pk2(s[0 * 33], s[1 * 33]); o.y = pk2(s[2 * 33], s[3 * 33]); o.z = pk2(s[4 * 33], s[5 * 33]); o.w = pk2(s[6 * 33], s[7 * 33]);
        *(__attribute__((address_space(1))) u32x4*)(WT + (size_t)(row_off + n0 + n) * K + k0 + 8 * c) = o; }
    LDS_WAIT();
}
DI void rms_row_to_bf16(const float* xrow, bf16_t* orow, int lane) {
    const f32x4* xr = (const f32x4*)xrow + lane;
    f32x4 v[4]; float s = 0.f;
#pragma unroll
    for (int j = 0; j < 4; ++j) { v[j] = xr[64 * j]; s += (v[j].x * v[j].x + v[j].y * v[j].y) + (v[j].z * v[j].z + v[j].w * v[j].w); }
    const float rstd = 1.0f / sqrtf(wave_sum(s) * (1.f / DM) + EPS);
    u64* o8 = (u64*)orow + lane;
#pragma unroll
    for (int j = 0; j < 4; ++j) o8[64 * j] = (u64)pk2(v[j].x * rstd, v[j].y * rstd) | ((u64)pk2(v[j].z * rstd, v[j].w * rstd) << 32);
}
DI void norm_rows(const float* src, bf16_t* dst, int nrows, int gw, int NGW, int lane) {
    for (int m = gw; m < nrows; m += NGW) rms_row_to_bf16(src + (size_t)m * DM, dst + (size_t)m * DM, lane);
}

DI void prep_weights_a(const Params& p, unsigned char* smem, int gw, int NGW, int wave, int lane) {
    unsigned char* ws = p.ws;
    float* scr = (float*)(smem + wave * 8704);
    constexpr int I_AIN = 16 * 72, I_MKV = 16 * 16, I_C1 = 32 * 8;
    constexpr int NITEMS = I_AIN + 2 * I_MKV + 2 * I_C1;
    for (int it = gw; it < NITEMS; it += NGW) {
        int r = it;
        if (r < I_AIN) { wt_item(p.a_w_in, 1024, 2212, 72, p.attn_norm, (bf16_t*)(ws + WS_WAIN), 0, scr, r, lane); continue; } r -= I_AIN;
        if (r < 2 * I_MKV) { const int l = r / I_MKV; wt_item(p.w_mem_kv + (size_t)l * DM * 512, 1024, 512, 16, p.mem_norm + l * DM, (bf16_t*)(ws + WS_WMKV), l * 512, scr, r % I_MKV, lane); continue; } r -= 2 * I_MKV;
        { const int i = r / I_C1; wt_item(p.a_cmp_w1 + (size_t)i * 2048 * 256, 2048, 256, 8, nullptr, (bf16_t*)(ws + WS_WC1) + (size_t)i * 2048 * 256, 0, scr, r % I_C1, lane); }
    }
}
DI void prep_weights_b(const Params& p, unsigned char* smem, int gw, int NGW, int wave, int lane) {
    unsigned char* ws = p.ws;
    float* scr = (float*)(smem + wave * 8704);
    constexpr int I_AOUT = 16 * 32, I_UP = 16 * 128, I_DN = 64 * 32, I_KVS = 16 * 32, I_BIN = 16 * 56, I_BOUT = 12 * 32;
    constexpr int NITEMS = I_AOUT + 2 * I_UP + 2 * I_DN + I_KVS + I_BIN + I_BOUT;
    for (int it = gw; it < NITEMS; it += NGW) {
        int r = it;
        if (r < I_AOUT) { wt_item(p.a_w_out, 1024, 1024, 32, nullptr, (bf16_t*)(ws + WS_WAOUT), 0, scr, r, lane); continue; } r -= I_AOUT;
        if (r < 2 * I_UP) { const int l = r / I_UP; wt_item(p.w_up + (size_t)l * DM * FF, 1024, 4096, 128, p.mlp_norm + l * DM, (bf16_t*)(ws + WS_WUP) + (size_t)l * DM * FF, 0, scr, r % I_UP, lane); continue; } r -= 2 * I_UP;
        if (r < 2 * I_DN) { const int l = r / I_DN; wt_item(p.w_down + (size_t)l * DM * FF, 4096, 1024, 32, nullptr, (bf16_t*)(ws + WS_WDN) + (size_t)l * DM * FF, 0, scr, r % I_DN, lane); continue; } r -= 2 * I_DN;
        if (r < I_KVS) { wt_item(p.w_kv_shared, 1024, 1024, 32, p.kv_norm, (bf16_t*)(ws + WS_WKVB), 0, scr, r, lane); continue; } r -= I_KVS;
        if (r < I_BIN) { wt_item(p.b_w_in, 1024, 1792, 56, p.attn_norm + DM, (bf16_t*)(ws + WS_WKVB), 1024, scr, r, lane); continue; } r -= I_BIN;
        wt_item(p.b_w_out, 768, 1024, 32, nullptr, (bf16_t*)(ws + WS_WBOUT), 0, scr, r, lane);
    }
}
DI void phase_prep(const Params& p, unsigned char* smem, int gw, int NGW, int wave, int lane) {
    unsigned char* ws = p.ws;
    prep_weights_a(p, smem, gw, NGW, wave, lane);
    norm_rows(p.x, (bf16_t*)(ws + WS_H), T, gw, NGW, lane);
    norm_rows(p.mem, (bf16_t*)(ws + WS_MEMN), NB * NMEM, gw, NGW, lane);
    const int gtid = gw * 64 + lane, NT = NGW * 64;
    for (int idx = gtid; idx < 3 * T; idx += NT) ((float*)(ws + WS_RSS))[idx] = 0.f;
    float* rope = (float*)(ws + WS_ROPE);
    for (int idx = gtid; idx < S * 32; idx += NT) {
        const int pos = idx >> 5, fi = idx & 31;
        const float inv = powf(10000.0f, -(float)fi / 32.0f);
        const float ang = (float)pos * inv;
        const double ad = (double)ang; const double k = rint(ad * 0.15915494309189535); const float rr = (float)(ad - k * 6.283185307179586);
        rope[2 * idx] = cosf(rr); rope[2 * idx + 1] = sinf(rr);
    }
    if (gtid == 0) {
        auto mx = [](const float* w) { float m = 0.f; for (int i = 0; i < 64; ++i) m = fmaxf(m, fabsf(w[i])); return m; };
        const float aq = mx(p.a_q_norm), kvk = mx(p.kv_k_norm);
        float worst = fmaxf(aq * mx(p.a_k_norm + 64), aq * mx(p.a_k_norm + 128));
        worst = fmaxf(worst, fmaxf(mx(p.mem_q_norm) * mx(p.mem_k_norm), mx(p.mem_q_norm + 64) * mx(p.mem_k_norm + 64)));
        worst = fmaxf(worst, kvk * fmaxf(mx(p.b_q_norm), fmaxf(mx(p.b_q_norm + 64), mx(p.b_q_norm + 128))));
        *(int*)(ws + WS_FLAG) = (64.0f * SC2 * 1.03f * worst <= 60.0f) ? 1 : 0;
    }
    float* part = (float*)(ws + WS_B1PART);
    for (int idx = gtid; idx < 16 * 512; idx += NT) {
        const int kc = idx >> 9, in = idx & 511, i = in >> 8, n = in & 255;
        const float* w1 = p.a_cmp_w1 + (size_t)i * 2048 * 256 + (size_t)(kc * 128) * 256 + n; const float* ps = p.a_cmp_pos + i * 2048 + kc * 128;
        float a = 0.f;
        for (int k = 0; k < 128; ++k) a += ps[k] * w1[(size_t)k * 256];
        part[idx] = a;
    }
}
#define LAS __attribute__((address_space(3)))
#define XB_TMO      128
#define XB_XCNT(j)  (256  + 64 * (j))
#define XB_XSUB(j)  (1280 + 64 * (j))
#define XB_XGEN(j)  (2304 + 64 * (j))
#define XB_TOP      3328
#define XB_TOPGEN   3392
#define XCD_BAR_WORDS 3456
#define XB_SPIN_CAP (1u << 18)

__device__ __forceinline__ unsigned xb_ld(unsigned* p)              { return __hip_atomic_load(p, __ATOMIC_RELAXED, __HIP_MEMORY_SCOPE_AGENT); }
__device__ __forceinline__ unsigned xb_add(unsigned* p, unsigned v) { return __hip_atomic_fetch_add(p, v, __ATOMIC_RELAXED, __HIP_MEMORY_SCOPE_AGENT); }
__device__ __forceinline__ unsigned xb_xcc_id() { return (unsigned)__builtin_amdgcn_s_getreg((3 << 11) | 20) & 0xFu; }
#define XB_SPIN(cond, bar) do { unsigned _sp = 0; while (cond) { __builtin_amdgcn_s_sleep(1); \
    if ((++_sp & 255u) == 0u) { if (xb_ld(&(bar)[XB_TMO])) break; if (_sp > XB_SPIN_CAP) { atomicAdd(&(bar)[XB_TMO], 1u); break; } } } } while (0)

struct XcdBarrier {
    unsigned* bar; unsigned x;
    volatile LAS unsigned* st;
};

__device__ __forceinline__ XcdBarrier xcd_barrier_post(unsigned* bar, volatile LAS unsigned* st) {
    XcdBarrier b; b.bar = bar; b.x = xb_xcc_id(); b.st = st;
    if (threadIdx.x == 0) (void)xb_add(&bar[XB_XCNT(b.x)], 1u);
    return b;
}
__device__ __forceinline__ void xcd_barrier_complete(unsigned* bar, unsigned x, unsigned& nloc, unsigned& nx) {
    const unsigned G = gridDim.x * gridDim.y * gridDim.z;
    unsigned sum, cnt, mine, sp = 0u;
    for (;;) {
        sum = 0u; cnt = 0u; mine = 0u;
#pragma unroll
        for (unsigned j = 0; j < 16; ++j) { const unsigned c = xb_ld(&bar[XB_XCNT(j)]); sum += c; cnt += (c > 0u) ? 1u : 0u; mine = (j == x) ? c : mine; }
        if (sum == G) break;
        __builtin_amdgcn_s_sleep(1);
        if ((++sp & 255u) == 0u) { if (xb_ld(&bar[XB_TMO])) break; if (sp > XB_SPIN_CAP) { atomicAdd(&bar[XB_TMO], 1u); break; } }
    }
    nloc = mine > 0u ? mine : 1u; nx = cnt > 0u ? cnt : 1u;
}

__device__ __forceinline__ void xcd_barrier(const XcdBarrier& b) {
    asm volatile("s_waitcnt vmcnt(0)" ::: "memory");
    __syncthreads();
    if (threadIdx.x == 0) {
        unsigned* bar = b.bar;
        __builtin_amdgcn_s_waitcnt(0);
        unsigned nloc = b.st[0], nx = b.st[1];
        if (nloc == 0u) { xcd_barrier_complete(bar, b.x, nloc, nx); b.st[0] = nloc; b.st[1] = nx; }
        const unsigned old = xb_add(&bar[XB_XSUB(b.x)], 1u);
        const unsigned gen = old / nloc;
        if (old + 1u == (gen + 1u) * nloc) {
            __builtin_amdgcn_fence(__ATOMIC_RELEASE, "agent");
            asm volatile("s_waitcnt vmcnt(0)" ::: "memory");
            const unsigned og = xb_add(&bar[XB_TOP], 1u);
            const unsigned tg = og / nx;
            if (og + 1u == (tg + 1u) * nx) xb_add(&bar[XB_TOPGEN], 1u);
            else XB_SPIN(xb_ld(&bar[XB_TOPGEN]) == tg, bar);
            __builtin_amdgcn_fence(__ATOMIC_ACQUIRE, "agent");
            xb_add(&bar[XB_XGEN(b.x)], 1u);
            asm volatile("s_waitcnt vmcnt(0)" ::: "memory");
        } else {
            XB_SPIN(xb_ld(&bar[XB_XGEN(b.x)]) == gen, bar);
            __builtin_amdgcn_fence(__ATOMIC_ACQUIRE, "agent");
            asm volatile("s_waitcnt vmcnt(0)" ::: "memory");
        }
    }
    __syncthreads();
}

DI void unpack8(const u32x4& raw, float (&v)[8]) {
#pragma unroll
    for (int j = 0; j < 4; ++j) { v[2 * j] = bflo(raw[j]); v[2 * j + 1] = bfhi(raw[j]); }
}
DI u32x4 pack8f(const float (&v)[8]) { u32x4 o; for (int j = 0; j < 4; ++j) o[j] = pk2(v[2 * j], v[2 * j + 1]); return o; }
DI void seg_norm(float (&v)[8], const float* w, int sub, float qs) {
    float ss = 0.f;
#pragma unroll
    for (int e = 0; e < 8; ++e) ss += v[e] * v[e];
    ss += __builtin_bit_cast(float, __builtin_amdgcn_update_dpp(0, __builtin_bit_cast(int, ss), 0xB1, 0xF, 0xF, false));
    ss += __builtin_bit_cast(float, __builtin_amdgcn_update_dpp(0, __builtin_bit_cast(int, ss), 0x4E, 0xF, 0xF, false));
    ss += __builtin_bit_cast(float, __builtin_amdgcn_update_dpp(0, __builtin_bit_cast(int, ss), 0x141, 0xF, 0xF, false));
    const float rs = qs / sqrtf(ss * (1.f / 64.f) + EPS);
    const f32x4 w0 = *(const f32x4*)(w + sub * 8), w1 = *(const f32x4*)(w + sub * 8 + 4);
#pragma unroll
    for (int e = 0; e < 4; ++e) { v[e] = v[e] * rs * w0[e]; v[4 + e] = v[4 + e] * rs * w1[e]; }
}
DI void seg_rope(float (&v)[8], const float (&cs)[8], const float (&sn)[8], int sub) {
#pragma unroll
    for (int e = 0; e < 8; ++e) { const float py = __shfl_xor(v[e], 4); v[e] = (sub < 4) ? v[e] * cs[e] - py * sn[e] : py * sn[e] + v[e] * cs[e]; }
}
DI void load_rope(const float* rope, int pos, int sub, float (&cs)[8], float (&sn)[8]) {
    const f32x4* rp = (const f32x4*)(rope + ((size_t)pos * 32 + (sub & 3) * 8) * 2);
#pragma unroll
    for (int j = 0; j < 4; ++j) { const f32x4 t = rp[j]; cs[2 * j] = t.x; sn[2 * j] = t.y; cs[2 * j + 1] = t.z; sn[2 * j + 1] = t.w; }
}

DI size_t kfrag_off(int key, int sub) { return (size_t)(key >> 5) * 2048 + (sub * 32 + (key & 31)) * 8; }
#define GLD4(p) (*(const __attribute__((address_space(1))) u32x4*)(p))
#define GST4(p, v) (*(__attribute__((address_space(1))) u32x4*)(p) = (v))
DI bool post0_need(int seg) { return (seg >= 12 && seg < 21) || (seg >= 24 && seg < 27); }
DI void post0_seg(const Params& p, const u32x4 raw, int seg, int token, int sub, const float (&cs)[8], const float (&sn)[8]) {
    unsigned char* ws = p.ws;
    const int s = token & (S - 1), b = token >> 12;
    bf16_t* ptr = (bf16_t*)(ws + WS_PROJ0) + (size_t)token * PROJ_LD + seg * 64 + sub * 8;
    float v[8]; unpack8(raw, v);
    if (seg == 34) {
        float* gp = (float*)(ws + WS_GATES) + (size_t)token * 36 + sub * 8;
#pragma unroll
        for (int e = 0; e < 8; ++e) if (sub * 8 + e < 36) gp[e] = 1.0f / (1.0f + __expf(-v[e]));
        return;
    }
    if (seg >= 12 && seg < 18) {
        const int i = (seg - 12) / 3, g = (seg - 12) % 3;
        bf16_t* tb = (bf16_t*)(ws + WS_TB) + (size_t)i * CMP_ROWS_PAD * 2048;
        const int c1 = s >> 4, j1 = s & 15; const size_t rb = (size_t)(b * 3 + g) * NCMP;
        if (c1 <= 254) GST4(tb + (rb + c1) * 2048 + j1 * 64 + sub * 8, raw);
        if (c1 >= 1) GST4(tb + (rb + c1 - 1) * 2048 + (j1 + 16) * 64 + sub * 8, raw);
        return;
    }
    const float* w = p.a_q_norm; float qs = 1.0f;
    if (seg < 12) qs = SC2;
    else if (seg < 21) w = p.a_k_norm + 64;
    else if (seg < 27) w = p.a_k_norm + 128;
    else { w = p.mem_q_norm; qs = SC2; }
    seg_norm(v, w, sub, qs);
    if (seg >= 30) { GST4(ptr, pack8f(v)); return; }
    seg_rope(v, cs, sn, sub);
    if (seg < 12) GST4(ptr, pack8f(v));
    else { const int g = (seg - 18) % 6, which = (seg - 18) / 6;
        bf16_t* kf = (bf16_t*)(ws + (which ? WS_KWINF : WS_KSELF)) + (size_t)(b * 3 + g) * S * 64;
        GST4(kf + kfrag_off(s, sub), pack8f(v)); }
}
DI bool post1_need(int seg) { return seg < 8; }
DI void post1_seg(const Params& p, const u32x4 raw, int seg, int token, int sub, const float (&cs)[8], const float (&sn)[8]) {
    unsigned char* ws = p.ws;
    const int s = token & (S - 1);
    bf16_t* ptr = (bf16_t*)(ws + WS_QKV1) + (size_t)token * QKV1_LD + seg * 64 + sub * 8;
    float v[8]; unpack8(raw, v);
    const float* w = p.kv_k_norm; float qs = 1.0f;
    if (seg >= 40) { w = p.mem_q_norm + 64; qs = SC2; }
    else if (seg >= 16) { w = p.b_q_norm + ((seg - 16) >> 3) * 64; qs = SC2; }
    seg_norm(v, w, sub, qs);
    if (seg >= 40) { GST4(ptr, pack8f(v)); return; }
    seg_rope(v, cs, sn, sub);
    const u32x4 o = pack8f(v);
    if (seg >= 16) GST4(ptr, o);
    else {
        const size_t hb = (size_t)((token >> 12) * 8 + seg) * S * 64;
        GST4((bf16_t*)(ws + WS_KF1) + hb + kfrag_off(s, sub), o);
        GST4((bf16_t*)(ws + WS_KF4) + hb + (size_t)(s & 3) * (S / 4) * 64 + kfrag_off(s >> 2, sub), o);
        GST4((bf16_t*)(ws + WS_KF16) + hb + (size_t)(s & 15) * (S / 16) * 64 + kfrag_off(s >> 4, sub), o);
    }
}
template <int LAYER>
DI void post_rows(const Params& p, int gw, int NGW, int lane) {
    unsigned char* ws = p.ws;
    constexpr int NSEG = LAYER == 0 ? 36 : 44, LD = LAYER == 0 ? PROJ_LD : QKV1_LD, NCH = NSEG / 4;
    const int sub = lane & 7, tl = lane >> 3;
    for (int g8 = gw; g8 < T / 8; g8 += NGW) {
        const int token = g8 * 8 + tl;
        const bf16_t* rowl = (const bf16_t*)(ws + (LAYER == 0 ? WS_PROJ0 : WS_QKV1)) + (size_t)token * LD + sub * 8;
        float cs[8], sn[8]; load_rope((const float*)(ws + WS_ROPE), token & (S - 1), sub, cs, sn);
        u32x4 ra[4], rb[4];
#pragma unroll
        for (int j = 0; j < 4; ++j) if (LAYER == 0 ? post0_need(j) : post1_need(j)) ra[j] = GLD4(rowl + j * 64);
#pragma unroll 1
        for (int c = 0; c < NCH; c += 2) {
            if (c + 1 < NCH) {
#pragma unroll
                for (int j = 0; j < 4; ++j) { const int seg = (c + 1) * 4 + j; if (LAYER == 0 ? post0_need(seg) : post1_need(seg)) rb[j] = GLD4(rowl + seg * 64); }
            }
#pragma unroll
            for (int j = 0; j < 4; ++j) { const int seg = c * 4 + j; if (LAYER == 0) { if (post0_need(seg)) post0_seg(p, ra[j], seg, token, sub, cs, sn); } else { if (post1_need(seg)) post1_seg(p, ra[j], seg, token, sub, cs, sn); } }
            if (c + 1 >= NCH) break;
            if (c + 2 < NCH) {
#pragma unroll
                for (int j = 0; j < 4; ++j) { const int seg = (c + 2) * 4 + j; if (LAYER == 0 ? post0_need(seg) : post1_need(seg)) ra[j] = GLD4(rowl + seg * 64); }
            }
#pragma unroll
            for (int j = 0; j < 4; ++j) { const int seg = (c + 1) * 4 + j; if (LAYER == 0) { if (post0_need(seg)) post0_seg(p, rb[j], seg, token, sub, cs, sn); } else { if (post1_need(seg)) post1_seg(p, rb[j], seg, token, sub, cs, sn); } }
        }
    }
}
DI void memk_row(const Params& p, int m, int lane) {
    bf16_t* row = (bf16_t*)(p.ws + WS_MEMKV) + (size_t)m * 1024;
    const int sub = lane & 7, sgl = lane >> 3, l = sgl >> 2, mh = sgl & 3;
    bf16_t* ptr = row + l * 512 + mh * 64 + sub * 8;
    const u32x4 raw = *(const u32x4*)ptr; float v[8]; unpack8(raw, v);
    seg_norm(v, p.mem_k_norm + l * 64, sub, 1.0f);
    bf16_t* kf = (bf16_t*)(p.ws + WS_MEMKF) + (size_t)((l * 8 + (m >> 8)) * 4 + mh) * NMEM * 64;
    *(u32x4*)(kf + kfrag_off(m & 255, sub)) = pack8f(v);
}
DI void vf_load(u32x4 (&v)[8], const bf16_t* src, size_t src_rs, int lane) {
    const int sub = lane & 7, rr = lane >> 3;
#pragma unroll
    for (int i = 0; i < 8; ++i) v[i] = GLD4(src + (size_t)(i * 8 + rr) * src_rs + sub * 8);
}
DI void vf_proc(const u32x4 (&v)[8], bf16_t* dst, bf16_t* scr, int lane) {
    const int sub = lane & 7, rr = lane >> 3;
#pragma unroll
    for (int i = 0; i < 8; ++i) { const int rw = i * 8 + rr; unsigned* d = (unsigned*)(scr + rw * 66 + sub * 8); d[0] = v[i].x; d[1] = v[i].y; d[2] = v[i].z; d[3] = v[i].w; }
    LDS_WAIT();
    const int h = lane >> 5, r = lane & 31;
#pragma unroll
    for (int i = 0; i < 8; ++i) { const int blk = i & 1, si = (i >> 1) & 1, tl = i >> 2;
        const bf16_t* sp = scr + (tl * 32 + 16 * si + 4 * h) * 66 + 32 * blk + r;
        u32x4 o;
#pragma unroll
        for (int j2 = 0; j2 < 4; ++j2) { const int k0 = 8 * (j2 >> 1) + 2 * (j2 & 1); o[j2] = (unsigned)sp[k0 * 66] | ((unsigned)sp[(k0 + 1) * 66] << 16); }
        GST4(dst + (size_t)(i * 64 + lane) * 8, o); }
    LDS_WAIT();
}
DI void vf_item(const bf16_t* src, size_t src_rs, bf16_t* dst, bf16_t* scr, int lane) { u32x4 v[8]; vf_load(v, src, src_rs, lane); vf_proc(v, dst, scr, lane); }

DI void phase_post0(const Params& p, unsigned char* smem, int gw, int NGW, int wave, int lane) {
    unsigned char* ws = p.ws;
    post_rows<0>(p, gw, NGW, lane);
    bf16_t* scr = (bf16_t*)(smem + wave * 8704);
    auto geo = [&](int it, const bf16_t*& src, bf16_t*& dst) {
        const int which = it / (24 * 64), bg = (it / 64) % 24, ti = it % 64, b = bg / 3, g = bg % 3;
        src = (const bf16_t*)(ws + WS_PROJ0) + ((size_t)b * S + ti * 64) * PROJ_LD + (which ? 1728 : 1344) + g * 64;
        dst = (bf16_t*)(ws + (which ? WS_VWINF : WS_VSELF)) + (size_t)bg * 64 * S + (size_t)ti * 4096; };
    if (gw < 2 * 24 * 64) {
        u32x4 va[8], vb[8]; const bf16_t* src; bf16_t* dst; int it = gw;
        geo(it, src, dst); vf_load(va, src, PROJ_LD, lane);
        for (;;) {
            const int nit = it + NGW; const bool hn = nit < 2 * 24 * 64;
            const bf16_t* nsrc = src; bf16_t* ndst = dst;
            if (hn) { geo(nit, nsrc, ndst); vf_load(vb, nsrc, PROJ_LD, lane); }
            vf_proc(va, dst, scr, lane);
            if (!hn) break;
#pragma unroll
            for (int i = 0; i < 8; ++i) va[i] = vb[i];
            it = nit; dst = ndst; src = nsrc;
        }
    }
    const int gtid = gw * 64 + lane;
    if (gtid < 512) { const float* part = (const float*)(ws + WS_B1PART); float a = p.a_cmp_b1[gtid];
        for (int kc = 0; kc < 16; ++kc) a += part[kc * 512 + gtid];
        ((float*)(ws + WS_B1P))[gtid] = a; }
}
DI void phase_mempost(const Params& p, unsigned char* smem, int gw, int NGW, int wave, int lane) {
    unsigned char* ws = p.ws;
    for (int m = gw; m < NB * NMEM; m += NGW) memk_row(p, m, lane);
    bf16_t* scr = (bf16_t*)(smem + wave * 8704);
    for (int it = gw; it < 2 * 8 * 4 * 4; it += NGW) {
        const int ti = it & 3, mh = (it >> 2) & 3, b = (it >> 4) & 7, l = it >> 7;
        const bf16_t* src = (const bf16_t*)(ws + WS_MEMKV) + ((size_t)b * NMEM + ti * 64) * 1024 + l * 512 + 256 + mh * 64;
        bf16_t* dst = (bf16_t*)(ws + WS_MEMVF) + (size_t)((l * 8 + b) * 4 + mh) * 64 * NMEM + (size_t)ti * 4096;
        vf_item(src, 1024, dst, scr, lane);
    }
}
DI void phase_post1(const Params& p, unsigned char* smem, int gw, int NGW, int wave, int lane) {
    unsigned char* ws = p.ws;
    post_rows<1>(p, gw, NGW, lane);
    bf16_t* scr = (bf16_t*)(smem + wave * 8704);
    auto geo = [&](int it, const bf16_t*& src, size_t& rs, bf16_t*& dst) {
        const int gi = it / 4096, bh = (it / 64) % 64, q = it % 64, b = bh >> 3, hs = bh & 7;
        const int dil = gi == 0 ? 1 : (gi == 1 ? 4 : 16), clen = S / dil, tpc = clen / 64, rc = q / tpc, ti = q % tpc;
        src = (const bf16_t*)(ws + WS_QKV1) + ((size_t)b * S + rc + (size_t)dil * ti * 64) * QKV1_LD + 512 + hs * 64;
        dst = (bf16_t*)(ws + (gi == 0 ? WS_VF1 : (gi == 1 ? WS_VF4 : WS_VF16))) + (size_t)bh * 64 * S + ((size_t)rc * clen + ti * 64) * 64;
        rs = (size_t)dil * QKV1_LD; };
    if (gw < 3 * 64 * 64) {
        u32x4 va[8], vb[8]; const bf16_t* src; size_t rs; bf16_t* dst; int it = gw;
        geo(it, src, rs, dst); vf_load(va, src, rs, lane);
        for (;;) {
            const int nit = it + NGW; const bool hn = nit < 3 * 64 * 64;
            const bf16_t* nsrc = src; size_t nrs = rs; bf16_t* ndst = dst;
            if (hn) { geo(nit, nsrc, nrs, ndst); vf_load(vb, nsrc, nrs, lane); }
            vf_proc(va, dst, scr, lane);
            if (!hn) break;
#pragma unroll
            for (int i = 0; i < 8; ++i) va[i] = vb[i];
            it = nit; dst = ndst; src = nsrc; rs = nrs;
        }
    }
}
DI size_t vfrag_off(int key, int d) { const int kk = key & 31, si = kk >> 4, q = kk & 15, j = (q >> 3) * 4 + (q & 3), h = (q >> 2) & 1;
    return (size_t)(key >> 5) * 2048 + ((((si * 2 + (d >> 5)) * 2 + h) * 32 + (d & 31)) * 8 + j); }
DI void phase_cmp2(const Params& p, int gw, int NGW, int lane) {
    unsigned char* ws = p.ws;
    for (int it = gw; it < 2 * CMP_ROWS; it += NGW) {
        const int i = __builtin_amdgcn_readfirstlane(it / CMP_ROWS), rowi = __builtin_amdgcn_readfirstlane(it % CMP_ROWS);
        const int bg = rowi / NCMP, c = rowi % NCMP;
        const unsigned* hid = (const unsigned*)((const bf16_t*)(ws + WS_HID) + ((size_t)i * CMP_ROWS_PAD + rowi) * 256);
        const float* w2 = p.a_cmp_w2 + (size_t)i * 256 * 64 + lane;
        float acc = p.a_cmp_b2[i * 64 + lane], acc1 = 0.f, acc2 = 0.f, acc3 = 0.f;
#pragma unroll 4
        for (int k2 = 0; k2 < 128; k2 += 2) { const unsigned hv = hid[k2], hw = hid[k2 + 1];
            acc += bflo(hv) * w2[(2 * k2) * 64]; acc1 += bfhi(hv) * w2[(2 * k2 + 1) * 64];
            acc2 += bflo(hw) * w2[(2 * k2 + 2) * 64]; acc3 += bfhi(hw) * w2[(2 * k2 + 3) * 64]; }
        acc = (acc + acc1) + (acc2 + acc3);
        if (i == 0) {
            const float ss = wave_sum(acc * acc);
            float y = acc * (1.0f / sqrtf(ss * (1.f / 64.f) + EPS)) * p.a_k_norm[lane];
            const float* rp = (const float*)(ws + WS_ROPE) + ((size_t)(c * 16 + 31) * 32 + (lane & 31)) * 2;
            const float py = __shfl_xor(y, 32);
            y = (lane < 32) ? y * rp[0] - py * rp[1] : py * rp[1] + y * rp[0];
            bf16_t* kc = (bf16_t*)(ws + WS_KCF) + (size_t)bg * 256 * 64;
            kc[kfrag_off(c, lane >> 3) + (lane & 7)] = (bf16_t)f2bf(y);
            if (c == NCMP - 1) kc[kfrag_off(255, lane >> 3) + (lane & 7)] = 0;
        } else {
            bf16_t* vcf = (bf16_t*)(ws + WS_VCF) + (size_t)bg * 64 * 256;
            vcf[vfrag_off(c, lane)] = (bf16_t)f2bf(acc);
            if (c == NCMP - 1) vcf[vfrag_off(255, lane)] = 0;
        }
    }
}
struct Tile { int ko; int vo; int aux; };
#define GLD8(p) (*(const __attribute__((address_space(1))) bf16x8*)(p))
DI float rowmax16(const f32x16& s) {
    float r, t1, t2, t3, t4;
    asm("s_nop 7\n\ts_nop 7\n\t"
        "v_max3_f32 %0, %5, %6, %7\n\tv_max3_f32 %1, %8, %9, %10\n\tv_max3_f32 %2, %11, %12, %13\n\tv_max3_f32 %3, %14, %15, %16\n\tv_max3_f32 %4, %17, %18, %19\n\t"
        "v_max3_f32 %0, %0, %1, %2\n\tv_max3_f32 %3, %3, %4, %20\n\tv_max_f32 %0, %0, %3"
        : "=&v"(r), "=&v"(t1), "=&v"(t2), "=&v"(t3), "=&v"(t4)
        : "v"(s[0]), "v"(s[1]), "v"(s[2]), "v"(s[3]), "v"(s[4]), "v"(s[5]), "v"(s[6]), "v"(s[7]), "v"(s[8]), "v"(s[9]), "v"(s[10]), "v"(s[11]), "v"(s[12]), "v"(s[13]), "v"(s[14]), "v"(s[15]));
    return r;
}
template <bool FAST> struct FSx { float m, l; f32x16 o0, o1; static constexpr bool fast = FAST; };
template <class ST> DI void fs_init(ST& st) { st.m = ST::fast ? 0.f : -1e30f; st.l = 0.f; st.o0 = zero16(); st.o1 = zero16(); }
DI void load_q(bf16x8 (&qf)[4], const bf16_t* qrow, int h) {
#pragma unroll
    for (int ks = 0; ks < 4; ++ks) qf[ks] = GLD8(qrow + 16 * ks + 8 * h);
}
template <bool ROPE>
DI void load_q_norm(bf16x8 (&qf)[4], const bf16_t* qrow, const float* w, const float* rope_row, int h) {
    float v[4][8];
#pragma unroll
    for (int ks = 0; ks < 4; ++ks) { const u32x4 raw = *(const __attribute__((address_space(1))) u32x4*)(qrow + 16 * ks + 8 * h);
#pragma unroll
        for (int jj = 0; jj < 4; ++jj) { v[ks][2 * jj] = bflo(raw[jj]); v[ks][2 * jj + 1] = bfhi(raw[jj]); } }
    float ss = 0.f;
#pragma unroll
    for (int ks = 0; ks < 4; ++ks)
#pragma unroll
        for (int e = 0; e < 8; ++e) ss += v[ks][e] * v[ks][e];
    ss += __shfl_xor(ss, 32);
    const float rs = SC2 / sqrtf(ss * (1.f / 64.f) + EPS);
#pragma unroll
    for (int ks = 0; ks < 4; ++ks) { const f32x4 w0 = *(const f32x4*)(w + 16 * ks + 8 * h), w1 = *(const f32x4*)(w + 16 * ks + 8 * h + 4);
#pragma unroll
        for (int e = 0; e < 4; ++e) { v[ks][e] *= rs * w0[e]; v[ks][4 + e] *= rs * w1[e]; } }
    if (ROPE) {
#pragma unroll
        for (int hf = 0; hf < 2; ++hf) { const f32x4* rp = (const f32x4*)(rope_row + 2 * (16 * hf + 8 * h));
#pragma unroll
            for (int jj = 0; jj < 4; ++jj) { const f32x4 cs = rp[jj];
                { const float x1 = v[hf][2 * jj], x2 = v[hf + 2][2 * jj]; v[hf][2 * jj] = x1 * cs.x - x2 * cs.y; v[hf + 2][2 * jj] = x1 * cs.y + x2 * cs.x; }
                { const float x1 = v[hf][2 * jj + 1], x2 = v[hf + 2][2 * jj + 1]; v[hf][2 * jj + 1] = x1 * cs.z - x2 * cs.w; v[hf + 2][2 * jj + 1] = x1 * cs.w + x2 * cs.z; } } }
    }
#pragma unroll
    for (int ks = 0; ks < 4; ++ks) qf[ks] = __builtin_bit_cast(bf16x8, pack8f(v[ks]));
}
typedef float f32x2 __attribute__((ext_vector_type(2)));
template <class ST, class Mask>
DI void attend_tile(ST& st, const bf16x8 (&qf)[4], const bf16x8 (&kf)[4], const bf16x8 (&vf)[4], Mask& mask, int aux, int h) {
    f32x16 s = zero16();
#pragma unroll
    for (int ks = 0; ks < 4; ++ks) s = MFMA32(kf[ks], qf[ks], s);
    if (!mask.full(aux)) {
        const int d = mask.prep(aux);
#pragma unroll
        for (int i = 0; i < 16; ++i) s[i] = mask.elem(d, (i & 3) + 8 * (i >> 2)) ? s[i] : -INFINITY;
    }
    const bool on = mask.lane(aux);
    if constexpr (ST::fast) {
        f32x2 acc2 = {0.f, 0.f};
#pragma unroll
        for (int i = 0; i < 8; ++i) { f32x2 v; v.x = __builtin_amdgcn_exp2f(s[2 * i]); v.y = __builtin_amdgcn_exp2f(s[2 * i + 1]); s[2 * i] = v.x; s[2 * i + 1] = v.y; acc2 = acc2 + v; }
        st.l += on ? (acc2.x + acc2.y) : 0.f;
        const unsigned onm = on ? 0xffffffffu : 0u;
#pragma unroll
        for (int si = 0; si < 2; ++si) {
            u32x4 w = __builtin_bit_cast(u32x4, pack8(s, si)); w = w & onm;
            const bf16x8 pb = __builtin_bit_cast(bf16x8, w);
            st.o0 = MFMA32(vf[si * 2], pb, st.o0);
            st.o1 = MFMA32(vf[si * 2 + 1], pb, st.o1);
        }
        return;
    }
    float mx = rowmax16(s);
    mx = on ? mx : -INFINITY;
    if (__any(mx > st.m + 6.0f)) {
        mx = fmaxf(mx, __shfl_xor(mx, 32));
        const float mn = fmaxf(st.m, mx);
        const float alpha = __builtin_amdgcn_exp2f(st.m - mn);
        st.m = mn; st.l *= alpha; st.o0 = st.o0 * alpha; st.o1 = st.o1 * alpha;
    }
    const float msub = on ? st.m : INFINITY;
    f32x2 acc2 = {0.f, 0.f};
#pragma unroll
    for (int i = 0; i < 8; ++i) {
        f32x2 v = {s[2 * i], s[2 * i + 1]}; v = v - msub;
        v.x = __builtin_amdgcn_exp2f(v.x); v.y = __builtin_amdgcn_exp2f(v.y);
        s[2 * i] = v.x; s[2 * i + 1] = v.y; acc2 = acc2 + v;
    }
    st.l += acc2.x + acc2.y;
#pragma unroll
    for (int si = 0; si < 2; ++si) {
        const bf16x8 pb = pack8(s, si);
        st.o0 = MFMA32(vf[si * 2], pb, st.o0);
        st.o1 = MFMA32(vf[si * 2 + 1], pb, st.o1);
    }
}
DI void load_k(bf16x8 (&kf)[4], const bf16_t* kb, const Tile& t) {
#pragma unroll
    for (int q = 0; q < 4; ++q) kf[q] = GLD8(kb + t.ko + 512 * q);
}
DI void load_v(bf16x8 (&vf)[4], const bf16_t* vb, const Tile& t) {
#pragma unroll
    for (int q = 0; q < 4; ++q) vf[q] = GLD8(vb + t.vo + 512 * q);
}
template <class ST, class Next, class Mask>
DI void attend(ST& st, const bf16x8 (&qf)[4], const bf16_t* kb, const bf16_t* vb, Next& next, Mask& mask, int h) {
    Tile ta, tb;
    if (!next(ta)) return;
    bf16x8 kA[4], kB[4], vf[4];
    load_k(kA, kb, ta);
    for (;;) {
        const bool hb = next(tb);
        load_v(vf, vb, ta);
        if (hb) load_k(kB, kb, tb);
        attend_tile(st, qf, kA, vf, mask, ta.aux, h);
        if (!hb) break;
        const bool ha = next(ta);
        load_v(vf, vb, tb);
        if (ha) load_k(kA, kb, ta);
        attend_tile(st, qf, kB, vf, mask, tb.aux, h);
        if (!ha) break;
    }
}
template <class ST> DI float fs_inv(ST& st) { const float l = st.l + __shfl_xor(st.l, 32); return l > 0.f ? 1.0f / l : 0.f; }
DI void store_o(bf16_t* orow, const f32x16& a0, const f32x16& a1, int h) {
#pragma unroll
    for (int g = 0; g < 4; ++g) {
        u32x2 w0; w0.x = pk2(a0[4 * g], a0[4 * g + 1]); w0.y = pk2(a0[4 * g + 2], a0[4 * g + 3]);
        u32x2 w1; w1.x = pk2(a1[4 * g], a1[4 * g + 1]); w1.y = pk2(a1[4 * g + 2], a1[4 * g + 3]);
        *(__attribute__((address_space(1))) u32x2*)(orow + 8 * g + 4 * h) = w0; *(__attribute__((address_space(1))) u32x2*)(orow + 32 + 8 * g + 4 * h) = w1;
    }
}

template <bool FAST>
DI void mem_item(const Params& p, int layer, int it, int lane) {
    unsigned char* ws = p.ws;
    const int r = lane & 31, h = lane >> 5;
    const int tile = it & 127, mh = (it >> 7) & 3, b = it >> 9;
    const size_t tok = (size_t)b * S + tile * 32 + r;
    const bf16_t* qrow = layer == 0 ? (const bf16_t*)(ws + WS_PROJ0) + tok * PROJ_LD + 1920 + mh * 64 : (const bf16_t*)(ws + WS_QKV1) + tok * QKV1_LD + 2560 + mh * 64;
    bf16x8 qf[4]; load_q_norm<false>(qf, qrow, p.mem_q_norm + layer * 64, nullptr, h);
    const bf16_t* kb = (const bf16_t*)(ws + WS_MEMKF) + (size_t)((layer * 8 + b) * 4 + mh) * NMEM * 64 + lane * 8;
    const bf16_t* vb = (const bf16_t*)(ws + WS_MEMVF) + (size_t)((layer * 8 + b) * 4 + mh) * NMEM * 64 + lane * 8;
    int ti = 0;
    auto next = [&](Tile& t) -> bool { if (ti >= 8) return false; t.ko = ti * 2048; t.vo = ti * 2048; t.aux = 0; ++ti; return true; };
    struct { DI bool full(int) const { return true; } DI bool lane(int) const { return true; } DI int prep(int) const { return 0; } DI bool elem(int, int) const { return true; } } mask;
    FSx<FAST> st; fs_init(st);
    attend(st, qf, kb, vb, next, mask, h);
    const float inv = fs_inv(st);
    bf16_t* orow = layer == 0 ? (bf16_t*)(ws + WS_ATT0) + tok * 1024 + 768 + mh * 64 : (bf16_t*)(ws + WS_ATT1) + tok * 768 + 512 + mh * 64;
    store_o(orow, st.o0 * inv, st.o1 * inv, h);
}

template <class ST> DI void softmax_p(ST& st, f32x16& s, bf16x8 (&pk)[2], bool on) {
    if constexpr (ST::fast) {
        f32x2 acc2 = {0.f, 0.f};
#pragma unroll
        for (int i = 0; i < 8; ++i) { f32x2 v; v.x = __builtin_amdgcn_exp2f(s[2 * i]); v.y = __builtin_amdgcn_exp2f(s[2 * i + 1]); s[2 * i] = v.x; s[2 * i + 1] = v.y; acc2 = acc2 + v; }
        st.l += on ? (acc2.x + acc2.y) : 0.f;
        const unsigned onm = on ? 0xffffffffu : 0u;
#pragma unroll
        for (int si = 0; si < 2; ++si) { u32x4 w = __builtin_bit_cast(u32x4, pack8(s, si)); w = w & onm; pk[si] = __builtin_bit_cast(bf16x8, w); }
        return;
    }
    float mx = rowmax16(s);
    mx = on ? mx : -INFINITY;
    if (__any(mx > st.m + 6.0f)) {
        mx = fmaxf(mx, __shfl_xor(mx, 32));
        const float mn = fmaxf(st.m, mx);
        const float alpha = __builtin_amdgcn_exp2f(st.m - mn);
        st.m = mn; st.l *= alpha; st.o0 = st.o0 * alpha; st.o1 = st.o1 * alpha;
    }
    const float msub = on ? st.m : INFINITY;
    f32x2 acc2 = {0.f, 0.f};
#pragma unroll
    for (int i = 0; i < 8; ++i) {
        f32x2 v = {s[2 * i], s[2 * i + 1]}; v = v - msub;
        v.x = __builtin_amdgcn_exp2f(v.x); v.y = __builtin_amdgcn_exp2f(v.y);
        s[2 * i] = v.x; s[2 * i + 1] = v.y; acc2 = acc2 + v;
    }
    st.l += acc2.x + acc2.y;
#pragma unroll
    for (int si = 0; si < 2; ++si) pk[si] = pack8(s, si);
}
template <class ST> DI void pv_acc(ST& st, const bf16x8 (&pk)[2], const bf16x8 (&vf)[4]) {
#pragma unroll
    for (int si = 0; si < 2; ++si) { st.o0 = MFMA32(vf[si * 2], pk[si], st.o0); st.o1 = MFMA32(vf[si * 2 + 1], pk[si], st.o1); }
}
template <class ST, class Next, class Mask>
DI void attend2(ST& s0, ST& s1, const bf16x8 (&q0)[4], const bf16x8 (&q1)[4], const bf16_t* kb, const bf16_t* vb, Next& next, Mask& mask) {
    Tile cur;
    if (!next(cur)) return;
    bf16x8 kf[4], vf[4];
    load_k(kf, kb, cur);
    for (;;) {
        Tile nx; const bool hn = next(nx);
        load_v(vf, vb, cur);
        f32x16 sa = zero16(), sb = zero16();
#pragma unroll
        for (int ks = 0; ks < 4; ++ks) { sa = MFMA32(kf[ks], q0[ks], sa); sb = MFMA32(kf[ks], q1[ks], sb); }
        if (hn) load_k(kf, kb, nx);
        if (!mask.full(cur.aux)) {
            const int d = mask.prep(cur.aux);
#pragma unroll
            for (int i = 0; i < 16; ++i) { const bool ok = mask.elem(d, (i & 3) + 8 * (i >> 2)); sa[i] = ok ? sa[i] : -INFINITY; sb[i] = ok ? sb[i] : -INFINITY; }
        }
        const bool on = mask.lane(cur.aux);
        bf16x8 pa[2], pb[2];
        softmax_p(s0, sa, pa, on);
        softmax_p(s1, sb, pb, on);
        pv_acc(s0, pa, vf);
        pv_acc(s1, pb, vf);
        if (!hn) break;
        cur = nx;
    }
}
DI void rmw_o(bf16_t* orow, const f32x16& a0, const f32x16& a1, int h, bool first) {
#pragma unroll
    for (int g = 0; g < 4; ++g) {
        __attribute__((address_space(1))) u32x2* p0 = (__attribute__((address_space(1))) u32x2*)(orow + 8 * g + 4 * h);
        __attribute__((address_space(1))) u32x2* p1 = (__attribute__((address_space(1))) u32x2*)(orow + 32 + 8 * g + 4 * h);
        float b0[4] = {0.f, 0.f, 0.f, 0.f}, b1[4] = {0.f, 0.f, 0.f, 0.f};
        if (!first) { const u32x2 x0 = *p0, x1 = *p1; b0[0] = bflo(x0.x); b0[1] = bfhi(x0.x); b0[2] = bflo(x0.y); b0[3] = bfhi(x0.y); b1[0] = bflo(x1.x); b1[1] = bfhi(x1.x); b1[2] = bflo(x1.y); b1[3] = bfhi(x1.y); }
        u32x2 w0; w0.x = pk2(a0[4 * g] + b0[0], a0[4 * g + 1] + b0[1]); w0.y = pk2(a0[4 * g + 2] + b0[2], a0[4 * g + 3] + b0[3]);
        u32x2 w1; w1.x = pk2(a1[4 * g] + b1[0], a1[4 * g + 1] + b1[1]); w1.y = pk2(a1[4 * g + 2] + b1[2], a1[4 * g + 3] + b1[3]);
        *p0 = w0; *p1 = w1;
    }
}

template <bool FAST>
DI void nsa_item2(const Params& p, unsigned char* smem, int c64, int bg, bool valid, int w4, int slot, int lane) {
    unsigned char* ws = p.ws;
    const int b = bg / 3, g = bg % 3;
    const int r = lane & 31, h = lane >> 5, qh = w4 >> 1, hp = w4 & 1, head0 = g * 4 + hp * 2;
    const int t0 = c64 * 64 + qh * 32, t = t0 + r;
    const size_t tok = (size_t)b * S + t;
    const bf16_t* proj = (const bf16_t*)(ws + WS_PROJ0);
    float* imp = (float*)(smem + slot * 33792);
    u64* selmask = (u64*)(smem + 2 * 33792 + slot * 512);
    bf16x8 q0[4], q1[4];
    { const float* rr = (const float*)(ws + WS_ROPE) + (size_t)t * 64;
      load_q_norm<true>(q0, proj + tok * PROJ_LD + head0 * 64, p.a_q_norm, rr, h); load_q_norm<true>(q1, proj + tok * PROJ_LD + head0 * 64 + 64, p.a_q_norm, rr, h); }
    const bf16_t* gp = proj + tok * PROJ_LD + 2176 + head0 * 3;
    float gt[6];
#pragma unroll
    for (int i = 0; i < 6; ++i) gt[i] = 1.0f / (1.0f + __expf(-bf2f(gp[i])));
    const float gc0 = gt[0], gs0 = gt[1], gw0 = gt[2], gc1 = gt[3], gs1 = gt[4], gw1 = gt[5];
    bf16_t* orow = (bf16_t*)(ws + WS_ATT0) + tok * 1024 + head0 * 64;
    if (valid) {
        const bf16_t* kcb = (const bf16_t*)(ws + WS_KCF) + (size_t)bg * 256 * 64 + lane * 8;
        const bf16_t* vcb = (const bf16_t*)(ws + WS_VCF) + (size_t)bg * 256 * 64 + lane * 8;
        int ncv = t0 / 16 + 1; if (ncv > NCMP) ncv = NCMP;
        const int nct = (ncv + 31) >> 5;
        float m0 = -1e30f, l0 = 0.f, m1 = -1e30f, l1 = 0.f;
        bf16x8 kc[4], kn[4];
#pragma unroll
        for (int ks = 0; ks < 4; ++ks) kc[ks] = GLD8(kcb + 512 * ks);
#pragma unroll 1
        for (int ct = 0; ct < nct; ++ct) {
            const int cn = ct + 1 < nct ? ct + 1 : 0;
#pragma unroll
            for (int ks = 0; ks < 4; ++ks) kn[ks] = GLD8(kcb + cn * 2048 + 512 * ks);
            f32x16 sa = zero16(), sb = zero16();
#pragma unroll
            for (int ks = 0; ks < 4; ++ks) { sa = MFMA32(kc[ks], q0[ks], sa); sb = MFMA32(kc[ks], q1[ks], sb); }
#pragma unroll
            for (int ks = 0; ks < 4; ++ks) kc[ks] = kn[ks];
            float mxa = -INFINITY, mxb = -INFINITY;
#pragma unroll
            for (int i = 0; i < 16; ++i) { const int c = ct * 32 + crow(i, h); const bool ok = (c * 16 + 31 <= t); sa[i] = ok ? sa[i] : -INFINITY; sb[i] = ok ? sb[i] : -INFINITY; mxa = fmaxf(mxa, sa[i]); mxb = fmaxf(mxb, sb[i]); }
            mxa = fmaxf(mxa, __shfl_xor(mxa, 32)); mxb = fmaxf(mxb, __shfl_xor(mxb, 32));
            const float mna = fmaxf(m0, mxa), mnb = fmaxf(m1, mxb);
            float lsa = 0.f, lsb = 0.f;
#pragma unroll
            for (int i = 0; i < 16; ++i) { lsa += __builtin_amdgcn_exp2f(sa[i] - mna); lsb += __builtin_amdgcn_exp2f(sb[i] - mnb); }
            l0 = l0 * __builtin_amdgcn_exp2f(m0 - mna) + lsa; m0 = mna;
            l1 = l1 * __builtin_amdgcn_exp2f(m1 - mnb) + lsb; m1 = mnb;
        }
        l0 += __shfl_xor(l0, 32); l1 += __shfl_xor(l1, 32);
        const float il0 = l0 > 0.f ? 1.0f / l0 : 0.f, il1 = l1 > 0.f ? 1.0f / l1 : 0.f;
        f32x16 oa0 = zero16(), oa1 = zero16(), ob0 = zero16(), ob1 = zero16();
        float carry = 0.f;
        float* impw = imp + ((hp * 2 + qh) * 32 + r) * 65;
#pragma unroll 1
        for (int ct = 0; ct < 8; ++ct) {
            if (ct < nct) {
                bf16x8 vc[4];
#pragma unroll
                for (int q = 0; q < 4; ++q) vc[q] = GLD8(vcb + ct * 2048 + 512 * q);
                const int cn = ct + 1 < nct ? ct + 1 : ct;
#pragma unroll
                for (int ks = 0; ks < 4; ++ks) kn[ks] = GLD8(kcb + cn * 2048 + 512 * ks);
                f32x16 sa = zero16(), sb = zero16();
#pragma unroll
                for (int ks = 0; ks < 4; ++ks) { sa = MFMA32(kc[ks], q0[ks], sa); sb = MFMA32(kc[ks], q1[ks], sb); }
#pragma unroll
                for (int ks = 0; ks < 4; ++ks) kc[ks] = kn[ks];
#pragma unroll
                for (int i = 0; i < 16; ++i) { const int c = ct * 32 + crow(i, h); const bool ok = (c * 16 + 31 <= t);
                    sa[i] = ok ? __builtin_amdgcn_exp2f(sa[i] - m0) : 0.f; sb[i] = ok ? __builtin_amdgcn_exp2f(sb[i] - m1) : 0.f; }
#pragma unroll
                for (int si = 0; si < 2; ++si) {
                    const bf16x8 pa = pack8(sa, si), pb = pack8(sb, si);
                    oa0 = MFMA32(vc[2 * si], pa, oa0); oa1 = MFMA32(vc[2 * si + 1], pa, oa1);
                    ob0 = MFMA32(vc[2 * si], pb, ob0); ob1 = MFMA32(vc[2 * si + 1], pb, ob1);
                }
#pragma unroll
                for (int i = 0; i < 16; ++i) sa[i] = sa[i] * il0 + sb[i] * il1;
                float y3[4];
#pragma unroll
                for (int q = 0; q < 4; ++q) y3[q] = __shfl_xor(sa[4 * q + 3], 32);
#pragma unroll
                for (int q = 0; q < 4; ++q) {
                    const float quad = (sa[4 * q] + sa[4 * q + 1]) + (sa[4 * q + 2] + sa[4 * q + 3]);
                    const float prev = h ? y3[q] : (q ? y3[q > 0 ? q - 1 : 0] : carry);
                    impw[ct * 8 + 2 * q + h] = quad + prev;
                }
                carry = y3[3];
            } else {
#pragma unroll
                for (int q = 0; q < 4; ++q) impw[ct * 8 + 2 * q + h] = 0.f;
            }
        }
        const float f0 = gc0 * il0, f1 = gc1 * il1;
        rmw_o(orow, oa0 * f0, oa1 * f0, h, true);
        rmw_o(orow + 64, ob0 * f1, ob1 * f1, h, true);
    }
    __syncthreads();
    if (valid) {
        const int cur = c64, j = lane;
#pragma unroll 1
        for (int n0 = 0; n0 < 16; n0 += 4) {
            float v[4]; unsigned key[4], thr[4];
#pragma unroll
            for (int u = 0; u < 4; ++u) {
                const int tq = w4 * 16 + n0 + u, qh2 = tq >> 5, r2 = tq & 31;
                float x = imp[((0 * 2 + qh2) * 32 + r2) * 65 + j] + imp[((1 * 2 + qh2) * 32 + r2) * 65 + j];
                const bool forced = (j == 0) || (j == cur) || (j == cur - 1);
                x = forced ? 1e9f : (j <= cur ? x : -1e30f);
                v[u] = x;
                const unsigned vb = __builtin_bit_cast(unsigned, x); key[u] = (vb & 0x80000000u) ? ~vb : (vb | 0x80000000u); thr[u] = 0u;
            }
#pragma unroll
            for (int bit = 31; bit >= 0; --bit) {
#pragma unroll
                for (int u = 0; u < 4; ++u) { const unsigned cand = thr[u] | (1u << bit); if (__builtin_popcountll(__ballot(key[u] >= cand)) >= 16) thr[u] = cand; }
            }
#pragma unroll
            for (int u = 0; u < 4; ++u) {
                const u64 gt = __ballot(key[u] > thr[u]), eq = __ballot(key[u] == thr[u]);
                const int need = 16 - __builtin_popcountll(gt);
                const int eqrank = __builtin_popcountll(eq & ((1ull << j) - 1ull));
                const bool sel = ((key[u] > thr[u]) || (key[u] == thr[u] && eqrank < need)) && (v[u] > -5e29f);
                const u64 mk = __ballot(sel);
                if (lane == 0) selmask[w4 * 16 + n0 + u] = mk;
            }
        }
    }
    __syncthreads();
    if (valid) {
        {
            const u64 mym = selmask[qh * 32 + r];
            unsigned ulo = (unsigned)mym, uhi = (unsigned)(mym >> 32);
#pragma unroll
            for (int o = 1; o < 32; o <<= 1) { ulo |= __shfl_xor(ulo, o); uhi |= __shfl_xor(uhi, o); }
            u64 un = ((u64)(unsigned)__builtin_amdgcn_readfirstlane(uhi) << 32) | (unsigned)__builtin_amdgcn_readfirstlane(ulo);
            int sub = 0;
            const bf16_t* kb = (const bf16_t*)(ws + WS_KSELF) + (size_t)bg * S * 64 + lane * 8;
            const bf16_t* vb = (const bf16_t*)(ws + WS_VSELF) + (size_t)bg * S * 64 + lane * 8;
            auto next = [&](Tile& tl) -> bool {
                if (!un) return false;
                const int jb = __builtin_ctzll(un); const int pb = jb * 64 + sub * 32;
                tl.ko = pb * 64; tl.vo = pb * 64; tl.aux = pb;
                if (sub == 1 || pb + 32 > t0 + 31) { un &= un - 1; sub = 0; } else sub = 1;
                return true; };
            struct M { u64 mym; int th, t0; DI bool full(int pb) const { return pb + 31 <= t0; } DI bool lane(int pb) const { return (mym >> (pb >> 6)) & 1ull; } DI int prep(int pb) const { return th - pb; } DI bool elem(int d, int ci) const { return ci <= d; } } mask{mym, t - 4 * h, t0};
            FSx<FAST> s0, s1; fs_init(s0); fs_init(s1);
            attend2(s0, s1, q0, q1, kb, vb, next, mask);
            const float f0 = gs0 * fs_inv(s0), f1 = gs1 * fs_inv(s1);
            rmw_o(orow, s0.o0 * f0, s0.o1 * f0, h, false);
            rmw_o(orow + 64, s1.o0 * f1, s1.o1 * f1, h, false);
        }
        {
            int wt = (t0 >= 512 ? t0 - 512 : 0) >> 5; const int wend = t0 >> 5;
            const bf16_t* kb = (const bf16_t*)(ws + WS_KWINF) + (size_t)bg * S * 64 + lane * 8;
            const bf16_t* vb = (const bf16_t*)(ws + WS_VWINF) + (size_t)bg * S * 64 + lane * 8;
            auto next = [&](Tile& tl) -> bool { if (wt > wend) return false; const int pb = wt * 32; tl.ko = pb * 64; tl.vo = pb * 64; tl.aux = pb; ++wt; return true; };
            struct M { int th, t0; DI bool full(int pb) const { return pb + 31 <= t0 && pb >= t0 - 480; } DI bool lane(int) const { return true; } DI int prep(int pb) const { return th - pb; } DI bool elem(int d, int ci) const { return (unsigned)(d - ci) < 512u; } } mask{t - 4 * h, t0};
            FSx<FAST> s0, s1; fs_init(s0); fs_init(s1);
            attend2(s0, s1, q0, q1, kb, vb, next, mask);
            const float f0 = gw0 * fs_inv(s0), f1 = gw1 * fs_inv(s1);
            rmw_o(orow, s0.o0 * f0, s0.o1 * f0, h, false);
            rmw_o(orow + 64, s1.o0 * f1, s1.o1 * f1, h, false);
        }
    }
    __syncthreads();
}
template <bool FAST>
DI void phase_attn0_t(const Params& p, unsigned char* smem, int bid, int G, int wave, int lane) {
    const int slot = wave >> 2, w4 = wave & 3;
    if (wave >= 4) __builtin_amdgcn_s_setprio(1);
    if (G == 256) {
        const int xcd = bid & 7, l = bid >> 3;
        for (int rd = 0; rd < 3; ++rd) {
            int k = l;
            if (rd == 1) k = l < 16 ? 31 - 2 * l : 2 * (31 - l);
            else if (rd == 2) k = l == 0 ? 31 : (l < 16 ? l + 15 : l - 16);
            nsa_item2<FAST>(p, smem, 63 - (2 * k + slot), xcd + 8 * rd, true, w4, slot, lane);
        }
    } else {
        for (int rd = 0; rd * 2 * G < 1536; ++rd) {
            const int pr = rd * G + ((rd & 1) ? (G - 1 - bid) : bid), it = 2 * pr + slot;
            const bool valid = it < 1536; const int itc = valid ? it : 0;
            nsa_item2<FAST>(p, smem, 63 - itc / 24, itc % 24, valid, w4, slot, lane);
        }
    }
    const int gw = bid * 8 + wave, NGW = G * 8;
    for (int it = gw; it < 4096; it += NGW) mem_item<FAST>(p, 0, it, lane);
    __builtin_amdgcn_s_setprio(0);
}
DI void phase_attn0(const Params& p, unsigned char* smem, int bid, int G, int wave, int lane) {
    const bool fast = __builtin_amdgcn_readfirstlane(*(const int*)(p.ws + WS_FLAG)) != 0;
    if (fast) phase_attn0_t<true>(p, smem, bid, G, wave, lane); else phase_attn0_t<false>(p, smem, bid, G, wave, lane);
}

template <int GI, class ST>
DI void dil_group(const Params& p, ST& st, int b, int hs, int sp, int r16, int lane) {
    unsigned char* ws = p.ws;
    constexpr int dil = GI == 0 ? 1 : (GI == 1 ? 4 : 16), clen = S / dil;
    const int r = lane & 31, h = lane >> 5;
    const int t = sp * 512 + r16 + 16 * r, rc = r16 % dil, qc = t / dil;
    const bf16_t* qkv = (const bf16_t*)(ws + WS_QKV1);
    bf16x8 qf[4]; load_q_norm<true>(qf, qkv + ((size_t)b * S + t) * QKV1_LD + 1024 + GI * 512 + hs * 64, p.b_q_norm + GI * 64, (const float*)(ws + WS_ROPE) + (size_t)t * 64, h);
    const int cbase = sp * 512 / dil;
    int ti = (cbase >= 128 ? cbase - 128 : 0) >> 5; const int tend = (cbase + 512 / dil - 1) >> 5;
    const size_t cb = (size_t)(b * 8 + hs) * S * 64 + (size_t)rc * clen * 64 + lane * 8;
    const bf16_t* kb = (const bf16_t*)(ws + (GI == 0 ? WS_KF1 : (GI == 1 ? WS_KF4 : WS_KF16))) + cb;
    const bf16_t* vb = (const bf16_t*)(ws + (GI == 0 ? WS_VF1 : (GI == 1 ? WS_VF4 : WS_VF16))) + cb;
    auto next = [&](Tile& tl) -> bool { if (ti > tend) return false; const int k0 = ti * 32; tl.ko = k0 * 64; tl.vo = k0 * 64; tl.aux = k0; ++ti; return true; };
    struct M { int qh, lo, hi; DI bool full(int k0) const { return k0 >= lo && k0 <= hi; } DI bool lane(int) const { return true; } DI int prep(int k0) const { return qh - k0; } DI bool elem(int d, int ci) const { return (unsigned)(d - ci) <= 128u; } } mask{qc - 4 * h, GI == 2 ? sp * 32 - 97 : 1, GI == 2 ? sp * 32 - 31 : 0};
    attend(st, qf, kb, vb, next, mask, h);
}
template <int GI, bool FAST>
DI void dil_pass_a(const Params& p, bf16_t* os, float* lses, int b, int hs, int sp, int qt, int lane) {
    unsigned char* ws = p.ws;
    constexpr int dil = GI == 0 ? 1 : 4, clen = S / dil, nq = 16 / dil;
    const int r = lane & 31, h = lane >> 5;
    const int rc = qt / nq, qi = qt % nq;
    const int c0 = sp * (512 / dil) + qi * 32, qc = c0 + r;
    const int tl = rc + dil * (qi * 32 + r), t = sp * 512 + tl;
    const bf16_t* qkv = (const bf16_t*)(ws + WS_QKV1);
    bf16x8 qf[4]; load_q_norm<true>(qf, qkv + ((size_t)b * S + t) * QKV1_LD + 1024 + GI * 512 + hs * 64, p.b_q_norm + GI * 64, (const float*)(ws + WS_ROPE) + (size_t)t * 64, h);
    const size_t cb = (size_t)(b * 8 + hs) * S * 64 + (size_t)rc * clen * 64 + lane * 8;
    const bf16_t* kb = (const bf16_t*)(ws + (GI == 0 ? WS_KF1 : WS_KF4)) + cb; const bf16_t* vb = (const bf16_t*)(ws + (GI == 0 ? WS_VF1 : WS_VF4)) + cb;
    int k0 = c0 >= 128 ? c0 - 128 : 0;
    auto next = [&](Tile& tile) -> bool { if (k0 > c0) return false; tile.ko = k0 * 64; tile.vo = k0 * 64; tile.aux = k0; k0 += 32; return true; };
    struct M { int th, c0; DI bool full(int kk) const { return kk + 31 <= c0 && kk >= c0 - 96; } DI bool lane(int) const { return true; } DI int prep(int kk) const { return th - kk; } DI bool elem(int d, int ci) const { return (unsigned)(d - ci) <= 128u; } } mask{qc - 4 * h, c0};
    FSx<FAST> st; fs_init(st);
    attend(st, qf, kb, vb, next, mask, h);
    const float l = st.l + __shfl_xor(st.l, 32);
    const float inv = 1.0f / l;
    if (h == 0) lses[tl] = st.m + __builtin_amdgcn_logf(l);
    bf16_t* orow = os + tl * 68;
#pragma unroll
    for (int g = 0; g < 4; ++g) {
        u32x2 w0; w0.x = pk2(st.o0[4 * g] * inv, st.o0[4 * g + 1] * inv); w0.y = pk2(st.o0[4 * g + 2] * inv, st.o0[4 * g + 3] * inv);
        u32x2 w1; w1.x = pk2(st.o1[4 * g] * inv, st.o1[4 * g + 1] * inv); w1.y = pk2(st.o1[4 * g + 2] * inv, st.o1[4 * g + 3] * inv);
        *(u32x2*)(orow + 8 * g + 4 * h) = w0; *(u32x2*)(orow + 32 + 8 * g + 4 * h) = w1;
    }
}
template <bool FAST>
DI void dil_span_item(const Params& p, unsigned char* smem, int it, int wave, int lane) {
    unsigned char* ws = p.ws;
    const int sp = it & 7, hs = (it >> 3) & 7, b = it >> 6;
    const int r = lane & 31, h = lane >> 5;
    bf16_t* o0s = (bf16_t*)smem;
    bf16_t* o1s = (bf16_t*)(smem + 512 * 136);
    float* lse0 = (float*)(smem + 2 * 512 * 136);
    float* lse1 = lse0 + 512;
#pragma unroll 1
    for (int u = 0; u < 2; ++u) dil_pass_a<0, FAST>(p, o0s, lse0, b, hs, sp, wave * 2 + u, lane);
#pragma unroll 1
    for (int u = 0; u < 2; ++u) dil_pass_a<1, FAST>(p, o1s, lse1, b, hs, sp, wave * 2 + u, lane);
    __syncthreads();
#pragma unroll 1
    for (int u = 0; u < 2; ++u) {
        const int r16 = wave * 2 + u, tl = r16 + 16 * r, t = sp * 512 + tl;
        FSx<FAST> st; fs_init(st);
        dil_group<2>(p, st, b, hs, sp, r16, lane);
        const float l2 = st.l + __shfl_xor(st.l, 32);
        const float x2 = st.m + __builtin_amdgcn_logf(l2), x0 = lse0[tl], x1 = lse1[tl];
        const float mm = fmaxf(fmaxf(x0, x1), x2), e0 = __builtin_amdgcn_exp2f(x0 - mm), e1 = __builtin_amdgcn_exp2f(x1 - mm), e2 = __builtin_amdgcn_exp2f(x2 - mm), rden = 1.0f / (e0 + e1 + e2);
        const float a0 = e0 * rden, a1 = e1 * rden, a2 = e2 * rden / l2;
        const bf16_t* ra = o0s + tl * 68; const bf16_t* rb = o1s + tl * 68;
        f32x16 r0, r1;
#pragma unroll
        for (int g = 0; g < 4; ++g) {
            const u32x2 x0a = *(const u32x2*)(ra + 8 * g + 4 * h), x1a = *(const u32x2*)(ra + 32 + 8 * g + 4 * h);
            const u32x2 x0b = *(const u32x2*)(rb + 8 * g + 4 * h), x1b = *(const u32x2*)(rb + 32 + 8 * g + 4 * h);
            r0[4 * g] = st.o0[4 * g] * a2 + bflo(x0a.x) * a0 + bflo(x0b.x) * a1; r0[4 * g + 1] = st.o0[4 * g + 1] * a2 + bfhi(x0a.x) * a0 + bfhi(x0b.x) * a1;
            r0[4 * g + 2] = st.o0[4 * g + 2] * a2 + bflo(x0a.y) * a0 + bflo(x0b.y) * a1; r0[4 * g + 3] = st.o0[4 * g + 3] * a2 + bfhi(x0a.y) * a0 + bfhi(x0b.y) * a1;
            r1[4 * g] = st.o1[4 * g] * a2 + bflo(x1a.x) * a0 + bflo(x1b.x) * a1; r1[4 * g + 1] = st.o1[4 * g + 1] * a2 + bfhi(x1a.x) * a0 + bfhi(x1b.x) * a1;
            r1[4 * g + 2] = st.o1[4 * g + 2] * a2 + bflo(x1a.y) * a0 + bflo(x1b.y) * a1; r1[4 * g + 3] = st.o1[4 * g + 3] * a2 + bfhi(x1a.y) * a0 + bfhi(x1b.y) * a1;
        }
        store_o((bf16_t*)(ws + WS_ATT1) + ((size_t)b * S + t) * 768 + hs * 64, r0, r1, h);
    }
    __syncthreads();
}
template <bool FAST>
DI void phase_attn1_t(const Params& p, unsigned char* smem, int bid, int G, int wave, int lane) {
    const int gw = bid * 8 + wave, NGW = G * 8;
    if (wave >= 4) __builtin_amdgcn_s_setprio(1);
    if (G == 256) {
        const int xcd = bid & 7, l = bid >> 3;
        for (int rd = 0; rd < 2; ++rd) { const int bh = rd * 32 + xcd * 4 + (l >> 3); dil_span_item<FAST>(p, smem, bh * 8 + (l & 7), wave, lane); }
    } else {
        for (int it = bid; it < 512; it += G) dil_span_item<FAST>(p, smem, it, wave, lane);
    }
    for (int it = gw; it < 4096; it += NGW) mem_item<FAST>(p, 1, it, lane);
    __builtin_amdgcn_s_setprio(0);
}
DI void phase_attn1(const Params& p, unsigned char* smem, int bid, int G, int wave, int lane) {
    const bool fast = __builtin_amdgcn_readfirstlane(*(const int*)(p.ws + WS_FLAG)) != 0;
    if (fast) phase_attn1_t<true>(p, smem, bid, G, wave, lane); else phase_attn1_t<false>(p, smem, bid, G, wave, lane);
}
__global__ void __launch_bounds__(512, 2) yoco_fwd(Params pk) {
    extern __shared__ __attribute__((aligned(16))) unsigned char smem[];
    cg::grid_group grid = cg::this_grid();
    const int tid = threadIdx.x, lane = tid & 63, wave = __builtin_amdgcn_readfirstlane(tid >> 6);
    const int bid = blockIdx.x, G = gridDim.x, gw = bid * 8 + wave, NGW = G * 8;
    unsigned char* const ws = pk.ws;
    PG8_LAS unsigned char* lds = (PG8_LAS unsigned char*)smem;
    bf16_t* const Hb = (bf16_t*)(ws + WS_H);
    volatile LAS unsigned* misc = (volatile LAS unsigned*)((LAS unsigned char*)smem + LDS_MISC);
    if (tid < 2) misc[tid] = 0u;
    __syncthreads();
    const XcdBarrier xbar = xcd_barrier_post((unsigned*)(ws + WS_BAR), misc);
#define GSYNC() xcd_barrier(xbar)
#define GEMM_STORE(ACT, Aptr, Bptr, M_, N_, K_, Optr, LDC, BIAS) do { pg8::Gemm g{(const bf16_t*)(Aptr), (const bf16_t*)(Bptr), (M_), (N_), (K_)}; \
        pg8::EpiStore<ACT> E; E.O = (bf16_t*)(Optr); E.ldc = (LDC); E.bias = nullptr; E.rowss = (BIAS); pg8::StaticOrder So; So.init((M_), (N_), G, bid); \
        pg8::gemm_phase<pg8::EpiStore<ACT>, pg8::StaticOrder, true, true>(lds, g, So, E); } while (0)
#define GEMM_RES(Aptr, Bptr, K_, BASEF, BASEH, OUTF, HB, HB2, RSS) do { LDP(); pg8::Gemm g{(const bf16_t*)(Aptr), (const bf16_t*)(Bptr), T, DM, (K_)}; \
        pg8::EpiRes E; E.basef = (BASEF); E.baseh = (BASEH); E.outf = (OUTF); E.ldc = DM; E.hb = (HB); E.hb2 = (HB2); E.rowss = (RSS); pg8::StaticOrder So; So.init(T, DM, G, bid); \
        pg8::gemm_phase<pg8::EpiRes, pg8::StaticOrder, true, true>(lds, g, So, E); } while (0)
    float* const RS0 = (float*)(ws + WS_RSS);
#define NOF ((float*)nullptr)
#define NOH ((bf16_t*)nullptr)
    { if (bid == 0 && tid < (int)(sizeof(Params) / 8)) ((u64*)(ws + WS_PARAMS))[tid] = ((const u64*)&pk)[tid];
      phase_prep(pk, smem, gw, NGW, wave, lane); }
    if (pk.ws == nullptr) grid.sync();
    GSYNC();
#define LDP() const Params p = *(const Params*)(ws + WS_PARAMS)
    GEMM_STORE(0, Hb, ws + WS_WAIN, T, PROJ_LD, DM, ws + WS_PROJ0, PROJ_LD, nullptr);
    GSYNC();
    { LDP(); phase_post0(p, smem, gw, NGW, wave, lane); }
    GSYNC();
    if (G >= 80) {
        if (bid < 48) {
            const int i = bid / 24;
            pg8::Gemm g{(const bf16_t*)(ws + WS_TB) + (size_t)i * CMP_ROWS_PAD * 2048, (const bf16_t*)(ws + WS_WC1) + (size_t)i * 2048 * 256, CMP_ROWS_PAD, 256, 2048};
            pg8::EpiStore<1> E; E.O = (bf16_t*)(ws + WS_HID) + (size_t)i * CMP_ROWS_PAD * 256; E.ldc = 256; E.bias = (const float*)(ws + WS_B1P) + i * 256; E.rowss = nullptr;
            pg8::StaticOrder So; So.init(CMP_ROWS_PAD, 256, 24, bid - 24 * i);
            pg8::gemm_phase<pg8::EpiStore<1>, pg8::StaticOrder, true, true>(lds, g, So, E);
        } else if (bid < 80) {
            pg8::Gemm g{(const bf16_t*)(ws + WS_MEMN), (const bf16_t*)(ws + WS_WMKV), NB * NMEM, 1024, DM};
            pg8::EpiStore<0> E; E.O = (bf16_t*)(ws + WS_MEMKV); E.ldc = 1024; E.bias = nullptr; E.rowss = nullptr;
            pg8::StaticOrder So; So.init(NB * NMEM, 1024, 32, bid - 48);
            pg8::gemm_phase<pg8::EpiStore<0>, pg8::StaticOrder, true, true>(lds, g, So, E);
        } else { LDP(); prep_weights_b(p, smem, (bid - 80) * 8 + wave, (G - 80) * 8, wave, lane); }
    } else {
        { LDP(); prep_weights_b(p, smem, gw, NGW, wave, lane); }
        for (int i = 0; i < 2; ++i) {
            pg8::Gemm g{(const bf16_t*)(ws + WS_TB) + (size_t)i * CMP_ROWS_PAD * 2048, (const bf16_t*)(ws + WS_WC1) + (size_t)i * 2048 * 256, CMP_ROWS_PAD, 256, 2048};
            pg8::EpiStore<1> E; E.O = (bf16_t*)(ws + WS_HID) + (size_t)i * CMP_ROWS_PAD * 256; E.ldc = 256; E.bias = (const float*)(ws + WS_B1P) + i * 256; E.rowss = nullptr;
            pg8::StaticOrder So; So.init(CMP_ROWS_PAD, 256, G, bid);
            pg8::gemm_phase<pg8::EpiStore<1>, pg8::StaticOrder, true, true>(lds, g, So, E);
        }
        GEMM_STORE(0, ws + WS_MEMN, ws + WS_WMKV, NB * NMEM, 1024, DM, ws + WS_MEMKV, 1024, nullptr);
    }
    GSYNC();
    { LDP(); phase_cmp2(p, gw, NGW, lane); phase_mempost(p, smem, gw, NGW, wave, lane); }
    GSYNC();
    { LDP(); phase_attn0(p, smem, bid, G, wave, lane); }
    GSYNC();
    GEMM_RES(ws + WS_ATT0, ws + WS_WAOUT, 1024, p.x, NOH, NOF, Hb, NOH, RS0);
    GSYNC();
    GEMM_STORE(2, Hb, ws + WS_WUP, T, FF, DM, ws + WS_U, FF, RS0);
    GSYNC();
    GEMM_RES(ws + WS_U, ws + WS_WDN, FF, NOF, Hb, NOF, Hb, (bf16_t*)p.out, RS0 + T);
    GSYNC();
    GEMM_STORE(0, Hb, ws + WS_WKVB, T, QKV1_LD, DM, ws + WS_QKV1, QKV1_LD, RS0 + T);
    GSYNC();
    { LDP(); phase_post1(p, smem, gw, NGW, wave, lane); }
    GSYNC();
    { LDP(); phase_attn1(p, smem, bid, G, wave, lane); }
    GSYNC();
    GEMM_RES(ws + WS_ATT1, ws + WS_WBOUT, 768, NOF, (const bf16_t*)p.out, NOF, Hb, NOH, RS0 + 2 * T);
    GSYNC();
    GEMM_STORE(2, Hb, (const bf16_t*)(ws + WS_WUP) + (size_t)DM * FF, T, FF, DM, ws + WS_U, FF, RS0 + 2 * T);
    GSYNC();
    GEMM_RES(ws + WS_U, (const bf16_t*)(ws + WS_WDN) + (size_t)DM * FF, FF, NOF, Hb, p.out, NOH, NOH, NOF);
}

extern "C" void kernel_launch(void* const* d_in, const int* in_sizes, int n_in, void* d_out, int out_size, void* d_ws, size_t ws_size, hipStream_t stream) {
    static int grid = 0;
    if (grid == 0) {
        if (n_in != 25 || out_size != T * DM || ws_size < WS_END) { fprintf(stderr, "kernel_launch: unexpected problem (n_in %d, out %d, ws %zu)\n", n_in, out_size, ws_size); grid = -1; return; }
        int dev = 0, cus = 0, per_cu = 0;
        hipGetDevice(&dev); hipDeviceGetAttribute(&cus, hipDeviceAttributeMultiprocessorCount, dev);
        if (hipFuncSetAttribute((const void*)yoco_fwd, hipFuncAttributeMaxDynamicSharedMemorySize, LDS_BYTES) != hipSuccess) { fprintf(stderr, "kernel_launch: hipFuncSetAttribute failed\n"); grid = -1; return; }
        if (hipOccupancyMaxActiveBlocksPerMultiprocessor(&per_cu, (const void*)yoco_fwd, 512, LDS_BYTES) != hipSuccess || per_cu < 1) { fprintf(stderr, "kernel_launch: occupancy query says %d blocks/CU\n", per_cu); (void)hipGetLastError(); per_cu = 1; }
        grid = cus * 1;
        if (grid <= 0) grid = 256;
    }
    if (grid < 0) return;
    if (hipMemsetAsync((char*)d_ws + WS_BAR, 0, BAR_BYTES, stream) != hipSuccess) { fprintf(stderr, "kernel_launch: memset failed\n"); return; }
    Params p{};
    const float** pp = (const float**)&p;
    for (int i = 0; i < 25; ++i) pp[i] = (const float*)d_in[i];
    p.out = (float*)d_out; p.ws = (unsigned char*)d_ws;
    void* args[] = {&p};
    hipError_t e = hipLaunchCooperativeKernel((const void*)yoco_fwd, dim3(grid), dim3(512), args, LDS_BYTES, stream);
    if (e != hipSuccess) fprintf(stderr, "cooperative launch failed: %s (grid %d)\n", hipGetErrorString(e), grid);
}
```
